# Optimizing an MI355X kernel written in HIP

```python
import math
import jax, jax.numpy as jnp
from jax import lax
import numpy as np

D_MODEL = 1024
BATCH = 16
SEQ = 2048
DEPTH = 4

GRID_W = 64
CTX_LEN = 256
HEAD_DIM = 64
A_HEADS = 4
A_KV_HEADS = 2
Q_BLOCK = 128
ROPE_THETA = 10000.0
B_HEADS = 4
WIN_R = 8
WIN_C = 16
C_HEADS = 4
C_CONV = 3
D_HEADS = 4
D_KDIM = 32
D_GATE_RANK = 16
GLA_TAU = 16.0
CHUNK = 64
N_BRANCH = 4
N_GROUPS = 4
EXP_PER_GROUP = 8
N_EXPERTS = N_GROUPS * EXP_PER_GROUP
EXP_HIDDEN = 512
TOP_K = 2
EPS = 1e-6
DN_ALPHA = (2.0 * DEPTH) ** 0.25
DN_BETA = (8.0 * DEPTH) ** -0.25

A_QW = A_HEADS * HEAD_DIM
A_KVW = A_KV_HEADS * HEAD_DIM
B_W = B_HEADS * HEAD_DIM
C_W = C_HEADS * HEAD_DIM
D_KW = D_HEADS * D_KDIM
D_VW = D_HEADS * HEAD_DIM
IN_SPLITS = (
    ('a_q', A_QW), ('a_k', A_KVW), ('a_v', A_KVW),
    ('b_q', B_W), ('b_k', B_W), ('b_v', B_W),
    ('c_qkv', 3 * C_W), ('c_beta', 2 * C_HEADS), ('c_a', 2 * C_HEADS), ('c_g', C_W),
    ('d_q', D_KW), ('d_k', D_KW), ('d_v', D_VW), ('d_lr', 2 * D_GATE_RANK), ('d_g', D_VW),
    ('gates', N_BRANCH * D_MODEL),
)
IN_W = sum(w for _, w in IN_SPLITS)

kernel_name = 'hybrid_latent_diffusion_block'

F32 = jnp.float32


def split_in(proj):
    offs = np.cumsum([w for _, w in IN_SPLITS])[:-1].tolist()
    return dict(zip([n for n, _ in IN_SPLITS], jnp.split(proj, offs, axis=-1)))


def split_heads(x, h):
    b, n, _ = x.shape
    return x.reshape(b, n, h, -1).transpose(0, 2, 1, 3)


def merge_heads(x):
    b, h, n, d = x.shape
    return x.transpose(0, 2, 1, 3).reshape(b, n, h * d)


def rms_norm(x, g):
    xf = x.astype(F32)
    y = xf * lax.rsqrt(jnp.mean(xf * xf, axis=-1, keepdims=True) + EPS)
    return (y * g.astype(F32)).astype(x.dtype)


def layer_norm(x, g, b):
    xf = x.astype(F32)
    mu = jnp.mean(xf, axis=-1, keepdims=True)
    var = jnp.mean(jnp.square(xf - mu), axis=-1, keepdims=True)
    return ((xf - mu) * lax.rsqrt(var + EPS) * g.astype(F32) + b.astype(F32)).astype(x.dtype)


def l2_normalize(x):
    return x * lax.rsqrt(jnp.sum(x * x, axis=-1, keepdims=True) + EPS)


def axial_rope_tables(n, dtype):
    t = jnp.arange(n, dtype=jnp.int32)
    row = (t // GRID_W).astype(F32)
    col = (t % GRID_W).astype(F32)
    nf = HEAD_DIM // 4
    inv = ROPE_THETA ** (-jnp.arange(nf, dtype=F32) / nf)
    ang_r = row[:, None] * inv
    ang_c = col[:, None] * inv
    return tuple(a.astype(dtype) for a in (jnp.cos(ang_r), jnp.sin(ang_r), jnp.cos(ang_c), jnp.sin(ang_c)))


def _rope_half(x, cos, sin):
    x1, x2 = jnp.split(x, 2, axis=-1)
    return jnp.concatenate([x1 * cos - x2 * sin, x1 * sin + x2 * cos], axis=-1)


def axial_rope(x, rope):
    cos_r, sin_r, cos_c, sin_c = rope
    xr, xc = jnp.split(x, 2, axis=-1)
    return jnp.concatenate([_rope_half(xr, cos_r, sin_r), _rope_half(xc, cos_c, sin_c)], axis=-1)


def gqa_mixer(q, k, v, qc, kc, vc, q_gain, k_gain, rope):
    scale = HEAD_DIM ** -0.5
    rep = A_HEADS // A_KV_HEADS
    q = axial_rope(rms_norm(split_heads(q, A_HEADS), q_gain), rope)
    k = axial_rope(rms_norm(split_heads(k, A_KV_HEADS), k_gain), rope)
    v = split_heads(v, A_KV_HEADS)
    qc = rms_norm(split_heads(qc, A_HEADS), q_gain)
    kc = rms_norm(split_heads(kc, A_KV_HEADS), k_gain)
    vc = split_heads(vc, A_KV_HEADS)
    b, _, s, _ = q.shape
    nc = qc.shape[2]
    k_all = jnp.concatenate([k, kc], axis=2)
    v_all = jnp.concatenate([v, vc], axis=2)
    nb = s // Q_BLOCK
    qb = jnp.moveaxis(q.reshape(b, A_KV_HEADS, rep, nb, Q_BLOCK, HEAD_DIM), 3, 0)

    def block(qi):
        sc = jnp.einsum('bgrqd,bgkd->bgrqk', qi, k_all).astype(F32) * scale
        p = jax.nn.softmax(sc, axis=-1).astype(v_all.dtype)
        return jnp.einsum('bgrqk,bgkd->bgrqd', p, v_all)

    o = lax.map(block, qb)
    o = jnp.moveaxis(o, 0, 3).reshape(b, A_HEADS, s, HEAD_DIM)
    qcg = qc.reshape(b, A_KV_HEADS, rep, nc, HEAD_DIM)
    scc = jnp.einsum('bgrqd,bgkd->bgrqk', qcg, kc).astype(F32) * scale
    pc = jax.nn.softmax(scc, axis=-1).astype(vc.dtype)
    oc = jnp.einsum('bgrqk,bgkd->bgrqd', pc, vc).reshape(b, A_HEADS, nc, HEAD_DIM)
    return merge_heads(o), merge_heads(oc)


def na_mixer(q, k, v, qc, kc, vc, rpb):
    scale = HEAD_DIM ** -0.5
    q, k, v = split_heads(q, B_HEADS), split_heads(k, B_HEADS), split_heads(v, B_HEADS)
    qc, kc, vc = split_heads(qc, B_HEADS), split_heads(kc, B_HEADS), split_heads(vc, B_HEADS)
    b, h, s, d = q.shape
    rows = s // GRID_W
    wr = min(WIN_R, rows)
    nl = wr * GRID_W
    qg = q.reshape(b, h, rows, GRID_W, d)
    kg = k.reshape(b, h, rows, GRID_W, d)
    vg = v.reshape(b, h, rows, GRID_W, d)
    r_idx = jnp.arange(rows, dtype=jnp.int32)
    row_start = jnp.clip(r_idx - wr // 2, 0, rows - wr)
    cols = jnp.arange(GRID_W, dtype=jnp.int32)
    col_start = jnp.clip(cols - WIN_C // 2, 0, GRID_W - WIN_C)
    col_ok = (cols[None, :] >= col_start[:, None]) & (cols[None, :] < col_start[:, None] + WIN_C)
    dc_idx = jnp.clip(cols[None, :] - cols[:, None] + WIN_C - 1, 0, 2 * WIN_C - 2)
    mask = jnp.broadcast_to(col_ok[:, None, :], (GRID_W, wr, GRID_W)).reshape(GRID_W, nl)

    def row_block(inp):
        q_r, r, rs = inp
        k_r = lax.dynamic_slice_in_dim(kg, rs, wr, axis=2).reshape(b, h, nl, d)
        v_r = lax.dynamic_slice_in_dim(vg, rs, wr, axis=2).reshape(b, h, nl, d)
        dr_idx = rs + jnp.arange(wr, dtype=jnp.int32) - r + WIN_R - 1
        bias = rpb[:, dr_idx[None, :, None], dc_idx[:, None, :]].reshape(h, GRID_W, nl)
        s_loc = jnp.einsum('bhqd,bhkd->bhqk', q_r, k_r).astype(F32) * scale + bias.astype(F32)
        s_loc = jnp.where(mask, s_loc, -jnp.inf)
        s_ctx = jnp.einsum('bhqd,bhkd->bhqk', q_r, kc).astype(F32) * scale
        p = jax.nn.softmax(jnp.concatenate([s_loc, s_ctx], axis=-1), axis=-1).astype(v.dtype)
        return (jnp.einsum('bhqk,bhkd->bhqd', p[..., :nl], v_r)
                + jnp.einsum('bhqk,bhkd->bhqd', p[..., nl:], vc))

    o = lax.map(row_block, (jnp.moveaxis(qg, 2, 0), r_idx, row_start))
    o = jnp.moveaxis(o, 0, 2).reshape(b, h, s, d)
    scc = jnp.einsum('bhqd,bhkd->bhqk', qc, kc).astype(F32) * scale
    oc = jnp.einsum('bhqk,bhkd->bhqd', jax.nn.softmax(scc, axis=-1).astype(vc.dtype), vc)
    return merge_heads(o), merge_heads(oc)


def _to_chunks(x):
    b, h, n = x.shape[:3]
    return jnp.moveaxis(x.reshape(b, h, n // CHUNK, CHUNK, *x.shape[3:]), 2, 0)


def _from_chunks(o):
    nc, b, h, c, dv = o.shape
    return jnp.moveaxis(o, 0, 2).reshape(b, h, nc * c, dv)


def gated_delta_chunked(q, k, v, beta, log_a, s0):
    dk = q.shape[-1]
    tri_incl = jnp.tril(jnp.ones((CHUNK, CHUNK), bool))
    tri_strict = jnp.tril(jnp.ones((CHUNK, CHUNK), bool), -1)
    eye = jnp.eye(CHUNK, dtype=F32)

    def step(s, inp):
        qc, kc, vc, bc, gc = inp
        g = jnp.cumsum(gc, axis=-1)
        decay = jnp.exp(jnp.where(tri_incl, g[..., :, None] - g[..., None, :], -jnp.inf))
        kk = jnp.einsum('bhid,bhjd->bhij', kc, kc)
        lmat = jnp.where(tri_strict, bc[..., :, None] * kk * decay, 0.0)
        rhs = jnp.concatenate([kc * (bc * jnp.exp(g))[..., None], vc * bc[..., None]], axis=-1)
        sol = lax.linalg.triangular_solve(eye + lmat, rhs, left_side=True, lower=True, unit_diagonal=True)
        w, u0 = sol[..., :dk], sol[..., dk:]
        u = u0 - jnp.einsum('bhcd,bhde->bhce', w, s)
        qk = jnp.einsum('bhid,bhjd->bhij', qc, kc) * decay
        o = (jnp.einsum('bhcd,bhde->bhce', qc * jnp.exp(g)[..., None], s)
             + jnp.einsum('bhij,bhje->bhie', qk, u))
        g_last = g[..., -1:]
        s_new = (s * jnp.exp(g_last)[..., None]
                 + jnp.einsum('bhcd,bhce->bhde', kc * jnp.exp(g_last - g)[..., None], u))
        return s_new, o

    s_fin, o = lax.scan(step, s0, tuple(_to_chunks(t) for t in (q, k, v, beta, log_a)))
    return _from_chunks(o), s_fin


def gla_chunked(q, k, v, log_a, s0):
    tri_incl = jnp.tril(jnp.ones((CHUNK, CHUNK), bool))[:, :, None]

    def step(s, inp):
        qc, kc, vc, gc = inp
        g = jnp.cumsum(gc, axis=2)
        diff = g[:, :, :, None, :] - g[:, :, None, :, :]
        decay = jnp.exp(jnp.where(tri_incl, diff, -jnp.inf))
        a = jnp.einsum('bhid,bhijd,bhjd->bhij', qc, decay, kc)
        o = (jnp.einsum('bhcd,bhde->bhce', qc * jnp.exp(g), s)
             + jnp.einsum('bhij,bhje->bhie', a, vc))
        g_last = g[:, :, -1:, :]
        s_new = (s * jnp.exp(g_last[:, :, 0, :])[..., None]
                 + jnp.einsum('bhcd,bhce->bhde', kc * jnp.exp(g_last - g), vc))
        return s_new, o

    s_fin, o = lax.scan(step, s0, tuple(_to_chunks(t) for t in (q, k, v, log_a)))
    return _from_chunks(o), s_fin


def _orient(t, d):
    return t if d == 0 else jnp.flip(t, axis=2)


def bidirectional_scan(scan_fn, lat, lat_dir, ctx, ctx_dir, s0):
    out_l, out_c = 0.0, 0.0
    for d in range(2):
        oc, sc = scan_fn(*[_orient(t, d) for t in ctx], *[_orient(g[d], d) for g in ctx_dir], s0)
        ol, _ = scan_fn(*[_orient(t, d) for t in lat], *[_orient(g[d], d) for g in lat_dir], sc)
        out_l = out_l + _orient(ol, d)
        out_c = out_c + _orient(oc, d)
    return out_l, out_c


def _gated_out(o, gate, gain, n_heads):
    o = rms_norm(o, gain) * jax.nn.silu(split_heads(gate.astype(F32), n_heads))
    return merge_heads(o).astype(gate.dtype)


def short_conv(x, w):
    return lax.conv_general_dilated(x, w[:, None, :].astype(x.dtype), window_strides=(1,),
                                    padding=((C_CONV // 2, C_CONV // 2),),
                                    dimension_numbers=('NWC', 'WIO', 'NWC'),
                                    feature_group_count=x.shape[-1])


def _gdn_prep(qkv, beta_l, a_l, conv_w, a_log, dt_bias):
    b, n, _ = qkv.shape
    qkv = jax.nn.silu(short_conv(qkv, conv_w)).astype(F32)
    q, k, v = jnp.split(qkv, 3, axis=-1)
    q = l2_normalize(split_heads(q, C_HEADS)) * HEAD_DIM ** -0.5
    k = l2_normalize(split_heads(k, C_HEADS))
    v = split_heads(v, C_HEADS)
    beta = jax.nn.sigmoid(beta_l.astype(F32)).reshape(b, n, 2, C_HEADS).transpose(2, 0, 3, 1)
    a = a_l.astype(F32).reshape(b, n, 2, C_HEADS).transpose(2, 0, 3, 1)
    log_a = -jnp.exp(a_log.astype(F32))[:, None, :, None] * jax.nn.softplus(a + dt_bias.astype(F32)[:, None, :, None])
    return q, k, v, beta, log_a


def gdn_mixer(lat, ctx, conv_w, a_log, dt_bias, out_gain):
    ql, kl, vl, bl, gl = _gdn_prep(lat[0], lat[1], lat[2], conv_w, a_log, dt_bias)
    qc, kc, vc, bc, gc = _gdn_prep(ctx[0], ctx[1], ctx[2], conv_w, a_log, dt_bias)
    s0 = jnp.zeros((ql.shape[0], C_HEADS, HEAD_DIM, HEAD_DIM), F32)
    ol, oc = bidirectional_scan(gated_delta_chunked, (ql, kl, vl), (bl, gl), (qc, kc, vc), (bc, gc), s0)
    return _gated_out(ol, lat[3], out_gain, C_HEADS), _gated_out(oc, ctx[3], out_gain, C_HEADS)


def _gla_prep(q, k, v, lr, gw, gb):
    b, n, _ = q.shape
    q = split_heads(q.astype(F32), D_HEADS) * D_KDIM ** -0.5
    k = split_heads(k.astype(F32), D_HEADS)
    v = split_heads(v.astype(F32), D_HEADS)
    z = jnp.einsum('bnzr,zrk->bnzk', lr.astype(F32).reshape(b, n, 2, D_GATE_RANK), gw.astype(F32)) + gb.astype(F32)
    log_a = (jax.nn.log_sigmoid(z) / GLA_TAU).reshape(b, n, 2, D_HEADS, D_KDIM).transpose(2, 0, 3, 1, 4)
    return q, k, v, log_a


def gla_mixer(lat, ctx, gw, gb, out_gain):
    ql, kl, vl, gl = _gla_prep(lat[0], lat[1], lat[2], lat[3], gw, gb)
    qc, kc, vc, gc = _gla_prep(ctx[0], ctx[1], ctx[2], ctx[3], gw, gb)
    s0 = jnp.zeros((ql.shape[0], D_HEADS, D_KDIM, HEAD_DIM), F32)
    ol, oc = bidirectional_scan(gla_chunked, (ql, kl, vl), (gl,), (qc, kc, vc), (gc,), s0)
    return _gated_out(ol, lat[4], out_gain, D_HEADS), _gated_out(oc, ctx[4], out_gain, D_HEADS)


def merge_branches(branches, gates, w_br, w_o):
    o = jnp.stack(branches, axis=2)
    up = jnp.einsum('bnzc,zcd->bnzd', o, w_br)
    g = jax.nn.sigmoid(gates.reshape(*gates.shape[:-1], N_BRANCH, D_MODEL))
    return jnp.sum(g * up, axis=2) @ w_o


def mixer_sublayer(h, hc, w_in, w_br, w_o, a_qg, a_kg, rpb, c_conv, c_a_log, c_dt_bias, c_og,
                   d_gw, d_gb, d_og, rope, with_ctx):
    p = split_in(h @ w_in)
    pc = split_in(hc @ w_in)
    oa, oca = gqa_mixer(p['a_q'], p['a_k'], p['a_v'], pc['a_q'], pc['a_k'], pc['a_v'], a_qg, a_kg, rope)
    ob, ocb = na_mixer(p['b_q'], p['b_k'], p['b_v'], pc['b_q'], pc['b_k'], pc['b_v'], rpb)
    oc_, occ = gdn_mixer((p['c_qkv'], p['c_beta'], p['c_a'], p['c_g']),
                         (pc['c_qkv'], pc['c_beta'], pc['c_a'], pc['c_g']), c_conv, c_a_log, c_dt_bias, c_og)
    od, ocd = gla_mixer((p['d_q'], p['d_k'], p['d_v'], p['d_lr'], p['d_g']),
                        (pc['d_q'], pc['d_k'], pc['d_v'], pc['d_lr'], pc['d_g']), d_gw, d_gb, d_og)
    y = merge_branches((oa, ob, oc_, od), p['gates'], w_br, w_o)
    yc = merge_branches((oca, ocb, occ, ocd), pc['gates'], w_br, w_o) if with_ctx else None
    return y, yc


def hier_moe(h, w_rg, b_rg, w_re, b_re, w_up, w_gate, w_down):
    shp = h.shape
    t = h.reshape(-1, shp[-1])
    lg = (t @ w_rg).astype(F32) + b_rg.astype(F32)
    grp = jnp.argmax(lg, axis=-1)
    p_grp = jnp.take_along_axis(jax.nn.softmax(lg, axis=-1), grp[:, None], axis=-1)
    le = jnp.einsum('td,gde->tge', t, w_re).astype(F32) + b_re.astype(F32)
    le = jnp.take_along_axis(le, grp[:, None, None], axis=1)[:, 0]
    top_p, top_i = lax.top_k(jax.nn.softmax(le, axis=-1), TOP_K)
    wts = p_grp * top_p / jnp.sum(top_p, axis=-1, keepdims=True)
    eid = grp[:, None] * EXP_PER_GROUP + top_i
    dense = jnp.einsum('tk,tke->te', wts, jax.nn.one_hot(eid, N_EXPERTS, dtype=F32)).astype(h.dtype)
    y = jnp.zeros_like(t)
    for e in range(N_EXPERTS):
        a = jax.nn.silu(t @ w_gate[e]) * (t @ w_up[e])
        y = y + dense[:, e:e + 1] * (a @ w_down[e])
    return y.reshape(shp)


def setup_inputs(seed: int = 0) -> dict:
    key = jax.random.key(seed)
    ks = jax.random.split(key, 32)
    L, D = DEPTH, D_MODEL

    def nrm(k, shape, s):
        return jax.random.normal(k, shape, F32) * s

    dt = jnp.exp(jax.random.uniform(ks[12], (L, 2, C_HEADS), F32, math.log(1e-3), math.log(1e-1)))
    return {
        'x': nrm(ks[0], (BATCH, SEQ, D), 1.0),
        'c': nrm(ks[1], (BATCH, D), 1.0),
        'ctx': nrm(ks[2], (BATCH, CTX_LEN, D), 1.0),
        'c_ctx': nrm(ks[3], (D,), 1.0),
        'w_ada': nrm(ks[4], (L, D, 6 * D), 0.5 * D ** -0.5),
        'b_ada': nrm(ks[5], (L, 6 * D), 0.02),
        'w_in': nrm(ks[6], (L, D, IN_W), D ** -0.5),
        'a_q_gain': 1.0 + nrm(ks[7], (L, HEAD_DIM), 0.02),
        'a_k_gain': 1.0 + nrm(ks[8], (L, HEAD_DIM), 0.02),
        'b_rpb': nrm(ks[9], (L, B_HEADS, 2 * WIN_R - 1, 2 * WIN_C - 1), 0.1),
        'c_conv': nrm(ks[10], (L, C_CONV, 3 * C_W), C_CONV ** -0.5),
        'c_a_log': jnp.log(jax.random.uniform(ks[11], (L, 2, C_HEADS), F32, 1.0, 16.0)),
        'c_dt_bias': dt + jnp.log(-jnp.expm1(-dt)),
        'c_out_gain': 1.0 + nrm(ks[13], (L, HEAD_DIM), 0.02),
        'd_gate_w': nrm(ks[14], (L, 2, D_GATE_RANK, D_KW), D_GATE_RANK ** -0.5),
        'd_gate_b': nrm(ks[15], (L, 2, D_KW), 0.1),
        'd_out_gain': 1.0 + nrm(ks[16], (L, HEAD_DIM), 0.02),
        'w_branch': nrm(ks[17], (L, N_BRANCH, A_QW, D), A_QW ** -0.5),
        'w_out': nrm(ks[18], (L, D, D), D ** -0.5 * DN_BETA),
        'ln1_g': 1.0 + nrm(ks[19], (L, D), 0.02),
        'ln1_b': nrm(ks[20], (L, D), 0.02),
        'ln2_g': 1.0 + nrm(ks[21], (L, D), 0.02),
        'ln2_b': nrm(ks[22], (L, D), 0.02),
        'w_router_g': nrm(ks[23], (L, D, N_GROUPS), D ** -0.5),
        'b_router_g': nrm(ks[24], (L, N_GROUPS), 0.01),
        'w_router_e': nrm(ks[25], (L, N_GROUPS, D, EXP_PER_GROUP), D ** -0.5),
        'b_router_e': nrm(ks[26], (L, N_GROUPS, EXP_PER_GROUP), 0.01),
        'w_up': nrm(ks[27], (L, N_EXPERTS, D, EXP_HIDDEN), D ** -0.5),
        'w_gate': nrm(ks[28], (L, N_EXPERTS, D, EXP_HIDDEN), D ** -0.5),
        'w_down': nrm(ks[29], (L, N_EXPERTS, EXP_HIDDEN, D), EXP_HIDDEN ** -0.5 * DN_BETA),
    }


def reference(x, c, ctx, c_ctx, w_ada, b_ada, w_in, a_q_gain, a_k_gain, b_rpb, c_conv, c_a_log, c_dt_bias,
              c_out_gain, d_gate_w, d_gate_b, d_out_gain, w_branch, w_out, ln1_g, ln1_b, ln2_g, ln2_b,
              w_router_g, b_router_g, w_router_e, b_router_e, w_up, w_gate, w_down):
    rope = axial_rope_tables(x.shape[1], x.dtype)
    sc = jax.nn.silu(c)
    scc = jax.nn.silu(c_ctx)
    xc = ctx
    for l in range(DEPTH):
        with_ctx = l < DEPTH - 1
        mod = (sc @ w_ada[l] + b_ada[l])[:, None, :]
        modc = scc @ w_ada[l] + b_ada[l]
        sh1, s1, g1, sh2, s2, g2 = jnp.split(mod, 6, axis=-1)
        sh1c, s1c, g1c, sh2c, s2c, g2c = jnp.split(modc, 6, axis=-1)
        h = x * (1.0 + s1) + sh1
        hc = xc * (1.0 + s1c) + sh1c
        y, yc = mixer_sublayer(h, hc, w_in[l], w_branch[l], w_out[l], a_q_gain[l], a_k_gain[l], b_rpb[l],
                               c_conv[l], c_a_log[l], c_dt_bias[l], c_out_gain[l],
                               d_gate_w[l], d_gate_b[l], d_out_gain[l], rope, with_ctx)
        x = layer_norm(DN_ALPHA * x + g1 * y, ln1_g[l], ln1_b[l])
        h = x * (1.0 + s2) + sh2
        x = layer_norm(DN_ALPHA * x + g2 * hier_moe(h, w_router_g[l], b_router_g[l], w_router_e[l], b_router_e[l],
                                                   w_up[l], w_gate[l], w_down[l]), ln2_g[l], ln2_b[l])
        if with_ctx:
            xc = layer_norm(DN_ALPHA * xc + g1c * yc, ln1_g[l], ln1_b[l])
            hc = xc * (1.0 + s2c) + sh2c
            xc = layer_norm(DN_ALPHA * xc + g2c * hier_moe(hc, w_router_g[l], b_router_g[l], w_router_e[l],
                                                          b_router_e[l], w_up[l], w_gate[l], w_down[l]),
                            ln2_g[l], ln2_b[l])
    return x
```

```cpp
#include <hip/hip_runtime.h>
#include <stdint.h>
#include <stdio.h>

#ifndef MK_SINGLE
#define MK_SINGLE 1
#endif
#ifndef PROBE_MASK
#define PROBE_MASK 0
#endif

#define LAS __attribute__((address_space(3)))
__device__ __forceinline__ int lane_now() { int l; asm volatile("v_mbcnt_lo_u32_b32 %0, -1, 0\n\tv_mbcnt_hi_u32_b32 %0, -1, %0" : "=v"(l)); return l; }
#define TIDX(wv) ((int)((((unsigned)(wv)) << 6) | (unsigned)lane_now()))
typedef float f32x4 __attribute__((ext_vector_type(4)));
typedef float f32x2 __attribute__((ext_vector_type(2)));
typedef unsigned u32x4 __attribute__((ext_vector_type(4)));
typedef unsigned u32x2 __attribute__((ext_vector_type(2)));
typedef short bf16x8 __attribute__((ext_vector_type(8)));
typedef unsigned short bf16_t;

constexpr int D = 1024, NB = 16, S = 2048, NL = 4, NCTX = 256, HD = 64;
constexpr int TL = NB * S, TC = NB * NCTX, TT = TL + TC;
constexpr int INW = 7216, NPAD = 7424;
constexpr int C_AQ = 0, C_AK = 256, C_AV = 384, C_BQ = 512, C_BK = 768, C_BV = 1024, C_CQKV = 1280, C_CBETA = 2048, C_CA = 2056,
              C_CG = 2064, C_DQ = 2320, C_DK = 2448, C_DV = 2576, C_DLR = 2832, C_DG = 2864, C_GATES = 3120;
constexpr int NEXP = 32, EH = 512;
constexpr float EPS = 1e-6f;
constexpr float DN_ALPHA = 1.6817928305074290f;
constexpr int NTHR = 512;
constexpr int NPL = 13;
constexpr int NPH = 1 + NL * NPL;
constexpr int MOE_ROWS = 82176;

constexpr size_t MiB = 1u << 20;
constexpr size_t WS_CTL = 0, CTL_BYTES = 1 * MiB;
constexpr size_t WS_MOD = 1 * MiB;
constexpr size_t WS_GB = 19 * MiB;
constexpr size_t WS_WT = 22 * MiB;
constexpr size_t WS_LIST = 23 * MiB;
constexpr size_t WS_W = 33 * MiB;
constexpr size_t   W_IN = 0;
constexpr size_t   W_BR = W_IN + (size_t)NPAD * 1024 * 2;
constexpr size_t   W_OUT = W_BR + (size_t)4 * 1024 * 256 * 2;
constexpr size_t   W_GU = W_OUT + (size_t)1024 * 1024 * 2;
constexpr size_t   W_DN = W_GU + (size_t)32 * 1024 * 1024 * 2;
constexpr size_t   W_RE = W_DN + (size_t)32 * 1024 * 512 * 2;
constexpr size_t   W_RG = W_RE + (size_t)4 * 1024 * 8 * 4;
constexpr size_t   W_END = W_RG + (size_t)1024 * 4 * 4;
static_assert(W_END <= 128 * MiB, "weights region");
constexpr size_t WS_H = 161 * MiB;
constexpr size_t WS_P = 233 * MiB;
constexpr size_t   P_AS = 0;
constexpr size_t   P_HID = P_AS + (size_t)MOE_ROWS * 1024 * 2;
constexpr size_t   P_YE = P_HID + (size_t)MOE_ROWS * 512 * 2;
static_assert(P_YE + (size_t)MOE_ROWS * 1024 * 2 <= (size_t)TT * NPAD * 2, "MoE overlay");
constexpr size_t WS_O = 755 * MiB;
constexpr size_t WS_X = 827 * MiB;
constexpr size_t   X_CQ = 0;
constexpr size_t   X_LA = X_CQ + (size_t)TT * 768 * 2;
constexpr size_t   X_OC = X_LA + (size_t)TT * 256 * 4;
constexpr size_t   X_MG = 0;
constexpr size_t   X_Y = (size_t)TT * 1024 * 2;
constexpr size_t WS_CM = 971 * MiB;
constexpr size_t WS_CL = 1043 * MiB;
constexpr size_t WS_DL = 1115 * MiB;
constexpr size_t WS_DV = 21 * MiB + 256 * 1024;
constexpr size_t WS_END = 1151 * MiB;
constexpr int CW_BAR = 4096;
constexpr int CW_CNT = 16384;
constexpr int CW_Q = 20480;
constexpr int LDS_MISC = 143360;
constexpr int LDS_TAB = 143360 + 64;
constexpr int LDS_BYTES = 147456;

#define XB_TMO      128
#define XB_XCNT(j)  (256  + 64 * (j))
#define XB_XSUB(j)  (1280 + 64 * (j))
#define XB_XGEN(j)  (2304 + 64 * (j))
#define XB_TOP      3328
#define XB_TOPGEN   3392
#define XCD_BAR_WORDS 3456
#define XB_SPIN_CAP (1u << 24)

__device__ __forceinline__ unsigned xb_ld(unsigned* p)              { return __hip_atomic_load(p, __ATOMIC_RELAXED, __HIP_MEMORY_SCOPE_AGENT); }
__device__ __forceinline__ unsigned xb_add(unsigned* p, unsigned v) { return __hip_atomic_fetch_add(p, v, __ATOMIC_RELAXED, __HIP_MEMORY_SCOPE_AGENT); }
__device__ __forceinline__ unsigned xb_xcc_id() { return (unsigned)__builtin_amdgcn_s_getreg((3 << 11) | 20) & 0xFu; }
#define XB_SPIN(cond, bar) do { unsigned _sp = 0; while (cond) { __builtin_amdgcn_s_sleep(1); \
    if ((++_sp & 255u) == 0u) { if (xb_ld(&(bar)[XB_TMO])) break; if (_sp > XB_SPIN_CAP) { atomicAdd(&(bar)[XB_TMO], 1u); break; } } } } while (0)

struct XcdBarrier { unsigned* bar; unsigned x; volatile LAS unsigned* st; };

__device__ __forceinline__ XcdBarrier xcd_barrier_post(unsigned* bar, volatile LAS unsigned* st) {
    XcdBarrier b; b.bar = bar; b.x = xb_xcc_id(); b.st = st;
    if (threadIdx.x == 0) (void)xb_add(&bar[XB_XCNT(b.x)], 1u);
    return b;
}
__device__ __forceinline__ void xcd_barrier_complete(unsigned* bar, unsigned x, unsigned& nloc, unsigned& nx) {
    const unsigned G = gridDim.x * gridDim.y * gridDim.z;
    unsigned sum, cnt, mine, sp = 0u;
    for (;;) {
        sum = 0u; cnt = 0u; mine = 0u;
#pragma unroll
        for (unsigned j = 0; j < 16; ++j) { const unsigned c = xb_ld(&bar[XB_XCNT(j)]); sum += c; cnt += (c > 0u) ? 1u : 0u; mine = (j == x) ? c : mine; }
        if (sum == G) break;
        __builtin_amdgcn_s_sleep(1);
        if ((++sp & 255u) == 0u) { if (xb_ld(&bar[XB_TMO])) break; if (sp > XB_SPIN_CAP) { atomicAdd(&bar[XB_TMO], 1u); break; } }
    }
    nloc = mine > 0u ? mine : 1u; nx = cnt > 0u ? cnt : 1u;
}
__device__ __forceinline__ void xcd_barrier(const XcdBarrier& b, int wv) {
    asm volatile("s_waitcnt vmcnt(0)" ::: "memory");
    __syncthreads();
    if (TIDX(wv) == 0) {
        unsigned* bar = b.bar;
        __builtin_amdgcn_s_waitcnt(0);
        unsigned nloc = b.st[0], nx = b.st[1];
        if (nloc == 0u) { xcd_barrier_complete(bar, b.x, nloc, nx); b.st[0] = nloc; b.st[1] = nx; }
        const unsigned old = xb_add(&bar[XB_XSUB(b.x)], 1u);
        const unsigned gen = old / nloc;
        if (old + 1u == (gen + 1u) * nloc) {
            __builtin_amdgcn_fence(__ATOMIC_RELEASE, "agent");
            asm volatile("s_waitcnt vmcnt(0)" ::: "memory");
            const unsigned og = xb_add(&bar[XB_TOP], 1u);
            const unsigned tg = og / nx;
            if (og + 1u == (tg + 1u) * nx) xb_add(&bar[XB_TOPGEN], 1u);
            else XB_SPIN(xb_ld(&bar[XB_TOPGEN]) == tg, bar);
            __builtin_amdgcn_fence(__ATOMIC_ACQUIRE, "agent");
            xb_add(&bar[XB_XGEN(b.x)], 1u);
            asm volatile("s_waitcnt vmcnt(0)" ::: "memory");
        } else {
            XB_SPIN(xb_ld(&bar[XB_XGEN(b.x)]) == gen, bar);
            __builtin_amdgcn_fence(__ATOMIC_ACQUIRE, "agent");
            asm volatile("s_waitcnt vmcnt(0)" ::: "memory");
        }
    }
    __syncthreads();
}

struct Params { const float* in[30]; float* out; unsigned char* ws; int ph_lo, ph_hi; };
enum { I_X = 0, I_C, I_CTX, I_CCTX, I_WADA, I_BADA, I_WIN, I_AQG, I_AKG, I_RPB, I_CCONV, I_CALOG, I_CDTB, I_COG, I_DGW, I_DGB, I_DOG,
       I_WBR, I_WOUT, I_LN1G, I_LN1B, I_LN2G, I_LN2B, I_WRG, I_BRG, I_WRE, I_BRE, I_WUP, I_WGATE, I_WDOWN };

typedef const __attribute__((address_space(4))) Params* KP;
__device__ __forceinline__ KP kp_get() { KP k = (KP)__builtin_amdgcn_kernarg_segment_ptr(); asm volatile("" : "+s"(k)); return k; }
#if defined(__HIP_DEVICE_COMPILE__)
#define LOADP() const Params q = *kp_get()
#else
#define LOADP() const Params q = p
#endif
__device__ __forceinline__ int opq(int v) { asm volatile("" : "+v"(v)); return v; }
template <int X> __device__ __forceinline__ float shx(float v) { return __int_as_float(__builtin_amdgcn_ds_swizzle(__float_as_int(v), (X << 10) | 0x1f)); }
template <int CTRL> __device__ __forceinline__ float dppf(float v) { return __int_as_float(__builtin_amdgcn_update_dpp(0, __float_as_int(v), CTRL, 0xF, 0xF, true)); }
__device__ __forceinline__ float row16_sum(float v) { v += dppf<0xB1>(v); v += dppf<0x4E>(v); v += dppf<0x141>(v); v += dppf<0x140>(v); return v; }
__device__ __forceinline__ float wave_sum(float v) {
    v = row16_sum(v);
    v += __int_as_float(__builtin_amdgcn_update_dpp(__float_as_int(v), __float_as_int(v), 0x142, 0xA, 0xF, false));
    v += __int_as_float(__builtin_amdgcn_update_dpp(__float_as_int(v), __float_as_int(v), 0x143, 0xC, 0xF, false));
    return __int_as_float(__builtin_amdgcn_readlane(__float_as_int(v), 63));
}
__device__ __forceinline__ float sigm_fast(float x) { return __builtin_amdgcn_rcpf(1.f + __builtin_amdgcn_exp2f(-1.4426950408889634f * x)); }
__device__ __forceinline__ float silu_f(float x) { return x * sigm_fast(x); }
__device__ __forceinline__ float sigm_f(float x) { return sigm_fast(x); }
__device__ __forceinline__ float softplus_f(float x) { return x > 20.f ? x : __logf(1.f + __expf(x)); }
typedef _Float16 h16x4 __attribute__((ext_vector_type(4)));
__device__ __forceinline__ const float* xin_row(const Params& p, int r) { return r < TL ? p.in[I_X] + (size_t)r * D : p.in[I_CTX] + (size_t)(r - TL) * D; }
__device__ __forceinline__ f32x4 ldh4(const _Float16* q) { return __builtin_convertvector(*(const h16x4*)q, f32x4); }
__device__ __forceinline__ void sth4(_Float16* q, const f32x4 v) { *(h16x4*)q = __builtin_convertvector(v, h16x4); }
__device__ __forceinline__ int brow(int r) { return r < TL ? (r >> 11) : 16; }
__device__ __forceinline__ float bf2f(bf16_t v) { return __uint_as_float(((unsigned)v) << 16); }
__device__ __forceinline__ float bflo(unsigned w) { return __uint_as_float(w << 16); }
__device__ __forceinline__ float bfhi(unsigned w) { return __uint_as_float(w & 0xffff0000u); }
__device__ __forceinline__ unsigned f2bf(float f) { unsigned u = __float_as_uint(f); return (u + 0x7fffu + ((u >> 16) & 1u)) >> 16; }
typedef __bf16 bfv2 __attribute__((ext_vector_type(2)));
__device__ __forceinline__ unsigned pk2(float lo, float hi) { const f32x2 v = {lo, hi}; return __builtin_bit_cast(unsigned, __builtin_convertvector(v, bfv2)); }
__device__ __forceinline__ void unpack8(const u32x4 w, float (&f)[8]) { f[0] = bflo(w.x); f[1] = bfhi(w.x); f[2] = bflo(w.y); f[3] = bfhi(w.y); f[4] = bflo(w.z); f[5] = bfhi(w.z); f[6] = bflo(w.w); f[7] = bfhi(w.w); }

namespace pg8 {
#define PG8_LAS __attribute__((address_space(3)))
constexpr int BM = 256, BK = 64, HALF = 128, HTB = HALF * BK * 2, STAGE_BYTES = 8 * HTB, NXCD = 8, WGM = 8;
__host__ __device__ __forceinline__ int lds_byte(int r, int c) { const int st = (r >> 4) * 2 + (c >> 5), rr = r & 15, cc = c & 31, ob = rr * 64 + cc * 2; return st * 1024 + (ob ^ (((ob >> 9) & 1) << 5)); }
__host__ __device__ __forceinline__ void stage_rc(int b, int& R, int& C) { const int st = b / 1024, sb = b % 1024, swz = sb ^ (((sb >> 9) & 1) << 5); R = (st >> 1) * 16 + swz / 64; C = (st & 1) * 32 + (swz % 64) / 2; }
__host__ __device__ __forceinline__ int perm32(int rho) { const int n = rho >> 4, i = rho & 15; return 8 * (i >> 2) + 4 * n + (i & 3); }

struct Unit { int pm, pn, e; };
struct Gemm { const bf16_t* A; const bf16_t* Bt; int M, N, K, lda, ldb; size_t bstride; };

struct StaticOrder {
    int nM, nN, nwg, G, c;
    __device__ void init(int M, int N, int G_, int c_) { nM = M / BM; nN = N / BM; nwg = nM * nN; G = G_; c = c_; }
    __device__ bool next(int i, Unit& u) const {
        const long L = (long)i * G + c; if (L >= nwg) return false;
        int wgid = (int)L; { const int q = nwg / NXCD, r = nwg % NXCD, xcd = wgid % NXCD, off = wgid / NXCD; wgid = (xcd < r ? xcd * (q + 1) : r * (q + 1) + (xcd - r) * q) + off; }
        const int nig = WGM * nN, gid = wgid / nig, fm = gid * WGM, gsz = (nM - fm) < WGM ? (nM - fm) : WGM;
        u.pm = fm + ((wgid % nig) % gsz); u.pn = (wgid % nig) / gsz; u.e = 0; return true;
    }
    __device__ __forceinline__ void a_ready(const Unit&) const {}
    __device__ __forceinline__ void done(const Unit&) const {}
};
struct ExpertOrder {
    int nN, G, c; const PG8_LAS int* ts;
    __device__ bool next(int i, Unit& u) const {
        const int total = ts[32] * nN; const long L = (long)i * G + c; if (L >= total) return false;
        const int mt = (int)L / nN;
        const int ln = (int)__builtin_amdgcn_mbcnt_hi(~0u, __builtin_amdgcn_mbcnt_lo(~0u, 0u)); const int tv = ts[ln & 31];
        const int e = __builtin_popcountll(__builtin_amdgcn_ballot_w64(ln >= 1 && ln < 32 && tv <= mt));
        u.pm = mt; u.pn = (int)L % nN; u.e = e; return true;
    }
    __device__ __forceinline__ void a_ready(const Unit&) const {}
    __device__ __forceinline__ void done(const Unit&) const {}
    const unsigned* cnt; const int* lists;
    __device__ __forceinline__ int entry(const Unit& u, int rit) const { const int off = (u.pm - ts[u.e]) * BM + rit, cn = (int)cnt[u.e];
        const int v = lists[(size_t)u.e * (TT * 2) + (off < cn ? off : cn - 1)]; return off < cn ? v : -1; }
    __device__ __forceinline__ int arow(const Unit& u, int rit) const { const int en = entry(u, rit); return en < 0 ? 0 : (en >> 1); }
};

__device__ __forceinline__ unsigned cvt_pk_bf16(float lo, float hi) { unsigned r; asm volatile("v_cvt_pk_bf16_f32 %0, %1, %2" : "=v"(r) : "v"(lo), "v"(hi)); return r; }
struct EpiStore {
    static constexpr bool PERM = true;
    bf16_t* O; int ldc;
    __device__ __forceinline__ void operator()(const f32x4 (&acc)[2][2][4][2], const Unit& u, int wr, int wc, int fr, int fq) const {
        const int row0 = u.pm * BM + wr * 64 + fr, col0 = u.pn * BM + wc * 32 + 8 * fq;
#pragma unroll
        for (int ai = 0; ai < 2; ++ai)
#pragma unroll
            for (int m = 0; m < 4; ++m) { bf16_t* rowp = O + (size_t)(row0 + ai * HALF + m * 16) * ldc + col0;
#pragma unroll
                for (int bj = 0; bj < 2; ++bj) { const f32x4 v0 = acc[ai][bj][m][0], v1 = acc[ai][bj][m][1];
                    u32x4 w; w.x = cvt_pk_bf16(v0[0], v0[1]); w.y = cvt_pk_bf16(v0[2], v0[3]); w.z = cvt_pk_bf16(v1[0], v1[1]); w.w = cvt_pk_bf16(v1[2], v1[3]);
                    *(u32x4*)(rowp + bj * HALF) = w; } }
    }
};
template <class Sched> struct EpiScatter {
    static constexpr bool PERM = true;
    bf16_t* O; int ldc; const Sched* S;
    __device__ __forceinline__ void operator()(const f32x4 (&acc)[2][2][4][2], const Unit& u, int wr, int wc, int fr, int fq) const {
        const int col0 = u.pn * BM + wc * 32 + 8 * fq;
        int ens[2][4];
#pragma unroll
        for (int ai = 0; ai < 2; ++ai)
#pragma unroll
            for (int m = 0; m < 4; ++m) ens[ai][m] = S->entry(u, wr * 64 + fr + ai * HALF + m * 16);
        __builtin_amdgcn_sched_barrier(0);
#pragma unroll
        for (int ai = 0; ai < 2; ++ai)
#pragma unroll
            for (int m = 0; m < 4; ++m) { const int en = ens[ai][m];
                if (en >= 0) { bf16_t* rowp = O + (size_t)en * ldc + col0;
#pragma unroll
                    for (int bj = 0; bj < 2; ++bj) { const f32x4 v0 = acc[ai][bj][m][0], v1 = acc[ai][bj][m][1];
                        u32x4 w; w.x = cvt_pk_bf16(v0[0], v0[1]); w.y = cvt_pk_bf16(v0[2], v0[3]); w.z = cvt_pk_bf16(v1[0], v1[1]); w.w = cvt_pk_bf16(v1[2], v1[3]);
                        *(u32x4*)(rowp + bj * HALF) = w; } } }
    }
};
struct EpiSwiglu {
    static constexpr bool PERM = true;
    bf16_t* Hd; int ldc;
    __device__ __forceinline__ void operator()(const f32x4 (&acc)[2][2][4][2], const Unit& u, int wr, int wc, int fr, int fq) const {
        const int row0 = u.pm * BM + wr * 64 + fr, col0 = u.pn * HALF + wc * 32 + 8 * fq;
#pragma unroll
        for (int ai = 0; ai < 2; ++ai)
#pragma unroll
            for (int m = 0; m < 4; ++m) { bf16_t* rowp = Hd + (size_t)(row0 + ai * HALF + m * 16) * ldc + col0; float o[8];
#pragma unroll
                for (int n = 0; n < 2; ++n)
#pragma unroll
                    for (int j = 0; j < 4; ++j) { const float gt = acc[ai][0][m][n][j], up = acc[ai][1][m][n][j]; o[n * 4 + j] = gt * sigm_fast(gt) * up; }
                u32x4 w; w.x = cvt_pk_bf16(o[0], o[1]); w.y = cvt_pk_bf16(o[2], o[3]); w.z = cvt_pk_bf16(o[4], o[5]); w.w = cvt_pk_bf16(o[6], o[7]);
                *(u32x4*)rowp = w; }
    }
};

template <class Epi, class Sched>
__device__ __forceinline__ void gemm_phase(PG8_LAS unsigned char* lds, const Gemm g, const Sched& S, const Epi& E, int wv) {
    const int tid = opq(TIDX(wv)), wid = __builtin_amdgcn_readfirstlane(tid >> 6), lane = tid & 63, wr = wid >> 2, wc = wid & 3, fr = lane & 15, fq = lane >> 4;
    const int K = g.K, nt = K / BK;
    unsigned voffA[2], voffB[2];
#pragma unroll
    for (int i = 0; i < 2; ++i) { int R, C; stage_rc(tid * 16 + i * 8192, R, C); const int Rb = Epi::PERM ? ((R & ~31) + perm32(R & 31)) : R;
        voffA[i] = (unsigned)(R * g.lda + C) * 2u; voffB[i] = (unsigned)(Rb * g.ldb + C) * 2u; }
    const size_t kstep = (size_t)(BK * 2);
    const size_t hstepA = (size_t)HALF * g.lda * 2, hstepB = (size_t)HALF * g.ldb * 2;
    const size_t tstepA = 2 * hstepA, tstepB = 2 * hstepB;
    const unsigned ldsw = (unsigned)wid * 1024u;
    const int aoff = lds_byte(wr * 64 + fr, fq * 8), boff = lds_byte(wc * 32 + fr, fq * 8);
#define PG8_SA(b, h) (((b) * 2 + (h)) * HTB)
#define PG8_SB(b, h) ((4 + (b) * 2 + (h)) * HTB)
#define PG8_STAGE(bufoff, gbase, voff) do { _Pragma("unroll") for (int _i = 0; _i < 2; ++_i) \
        __builtin_amdgcn_global_load_lds((const unsigned*)((const char*)(gbase) + (voff)[_i]), (PG8_LAS unsigned*)(lds + (bufoff) + ldsw + _i * 8192), 16, 0, 0); } while (0)
#define PG8_LDA(dst, b, h) do { _Pragma("unroll") for (int m = 0; m < 4; ++m) _Pragma("unroll") for (int k = 0; k < 2; ++k) dst[m][k] = *(const PG8_LAS bf16x8*)(lds + PG8_SA(b, h) + aoff + m * 2048 + k * 1024); } while (0)
#define PG8_LDB(dst, b, h) do { _Pragma("unroll") for (int n = 0; n < 2; ++n) _Pragma("unroll") for (int k = 0; k < 2; ++k) dst[n][k] = *(const PG8_LAS bf16x8*)(lds + PG8_SB(b, h) + boff + n * 2048 + k * 1024); } while (0)
#define PG8_MMA(ai, bj, At, Bt) do { __builtin_amdgcn_s_setprio(1); _Pragma("unroll") for (int m = 0; m < 4; ++m) _Pragma("unroll") for (int n = 0; n < 2; ++n) _Pragma("unroll") for (int k = 0; k < 2; ++k) \
        acc[ai][bj][m][n] = __builtin_amdgcn_mfma_f32_16x16x32_bf16(Bt[n][k], At[m][k], acc[ai][bj][m][n], 0, 0, 0); __builtin_amdgcn_s_setprio(0); } while (0)
#define PG8_WAIT_V(n) asm volatile("s_waitcnt vmcnt(" #n ")" ::: "memory")
#define PG8_WAIT_L(n) asm volatile("s_waitcnt lgkmcnt(" #n ")" ::: "memory")
#define PG8_BAR __builtin_amdgcn_s_barrier()
#define PG8_SCHED __builtin_amdgcn_sched_barrier(0)
    Unit cur, nxt; int ui = 0;
    if (!S.next(0, cur)) return;
    f32x4 acc[2][2][4][2];
#pragma unroll
    for (int a = 0; a < 2; ++a)
#pragma unroll
        for (int b = 0; b < 2; ++b)
#pragma unroll
            for (int m = 0; m < 4; ++m)
#pragma unroll
                for (int n = 0; n < 2; ++n) acc[a][b][m][n] = (f32x4){0.f, 0.f, 0.f, 0.f};
    bf16x8 At[4][2], B0[2][2], B1[2][2];
    const char* cA = (const char*)g.A + (size_t)cur.pm * tstepA; const char* cB = (const char*)g.Bt + (size_t)cur.e * g.bstride * 2 + (size_t)cur.pn * tstepB;
    S.a_ready(cur);
    PG8_STAGE(PG8_SB(0, 0), cB, voffB); PG8_STAGE(PG8_SA(0, 0), cA, voffA); PG8_STAGE(PG8_SB(0, 1), cB + hstepB, voffB); PG8_STAGE(PG8_SA(0, 1), cA + hstepA, voffA);
    if (wr == 1) PG8_BAR;
    PG8_WAIT_V(4); PG8_BAR;
    PG8_STAGE(PG8_SB(1, 0), cB + kstep, voffB); PG8_STAGE(PG8_SA(1, 0), cA + kstep, voffA); PG8_STAGE(PG8_SB(1, 1), cB + hstepB + kstep, voffB);
    PG8_WAIT_V(6); PG8_BAR;
    for (;;) {
        const bool has_next = S.next(ui + 1, nxt);
        const char* nA = has_next ? (const char*)g.A + (size_t)nxt.pm * tstepA : cA;
        const char* nB = has_next ? (const char*)g.Bt + (size_t)nxt.e * g.bstride * 2 + (size_t)nxt.pn * tstepB : cB;
        for (int t = 0; t < nt; t += 2) {
            const bool last = (t == nt - 2);
            const char* a1 = cA + (size_t)(t + 1) * kstep;
            const char* a2 = last ? nA : cA + (size_t)(t + 2) * kstep; const char* b2 = last ? nB : cB + (size_t)(t + 2) * kstep;
            const char* a3 = a2 + kstep; const char* b3 = b2 + kstep;
            if (last && has_next) S.a_ready(nxt);
            PG8_LDB(B0, 0, 0); PG8_SCHED; PG8_LDA(At, 0, 0); PG8_STAGE(PG8_SA(1, 1), a1 + hstepA, voffA);
            PG8_WAIT_L(8); PG8_BAR; PG8_WAIT_L(0); PG8_MMA(0, 0, At, B0); PG8_BAR; PG8_SCHED;
            PG8_LDB(B1, 0, 1); PG8_STAGE(PG8_SB(0, 0), b2, voffB);
            PG8_BAR; PG8_WAIT_L(0); PG8_MMA(0, 1, At, B1); PG8_BAR;
            PG8_LDA(At, 0, 1); PG8_STAGE(PG8_SA(0, 0), a2, voffA);
            PG8_BAR; PG8_WAIT_L(0); PG8_MMA(1, 0, At, B0); PG8_BAR; PG8_SCHED;
            PG8_STAGE(PG8_SB(0, 1), b2 + hstepB, voffB);
            PG8_WAIT_V(6); PG8_BAR; PG8_MMA(1, 1, At, B1); PG8_BAR;
            PG8_LDB(B0, 1, 0); PG8_SCHED; PG8_LDA(At, 1, 0); PG8_STAGE(PG8_SA(0, 1), a2 + hstepA, voffA);
            PG8_WAIT_L(8); PG8_BAR; PG8_WAIT_L(0); PG8_MMA(0, 0, At, B0); PG8_BAR; PG8_SCHED;
            PG8_LDB(B1, 1, 1); PG8_STAGE(PG8_SB(1, 0), b3, voffB);
            PG8_BAR; PG8_WAIT_L(0); PG8_MMA(0, 1, At, B1); PG8_BAR;
            PG8_LDA(At, 1, 1); PG8_STAGE(PG8_SA(1, 0), a3, voffA);
            PG8_BAR; PG8_WAIT_L(0); PG8_MMA(1, 0, At, B0); PG8_BAR; PG8_SCHED;
            PG8_STAGE(PG8_SB(1, 1), b3 + hstepB, voffB);
            PG8_WAIT_V(6); PG8_BAR; PG8_MMA(1, 1, At, B1); PG8_BAR;
        }
        E(acc, cur, wr, wc, fr, fq); S.done(cur);
        if (!has_next) break;
#pragma unroll
        for (int a = 0; a < 2; ++a)
#pragma unroll
            for (int b = 0; b < 2; ++b)
#pragma unroll
                for (int m = 0; m < 4; ++m)
#pragma unroll
                    for (int n = 0; n < 2; ++n) acc[a][b][m][n] = (f32x4){0.f, 0.f, 0.f, 0.f};
        cur = nxt; cA = nA; cB = nB; ++ui;
    }
    PG8_WAIT_V(0);
    if (wr == 0) PG8_BAR;
    PG8_BAR;
#undef PG8_SA
#undef PG8_SB
#undef PG8_STAGE
#undef PG8_LDA
#undef PG8_LDB
#undef PG8_MMA
#undef PG8_WAIT_V
#undef PG8_WAIT_L
#undef PG8_BAR
#undef PG8_SCHED
}

template <class Epi, class Sched>
__device__ __forceinline__ void gemm_phase_gather(PG8_LAS unsigned char* lds, const Gemm g, const Sched& S, const Epi& E, int wv) {
    const int tid = opq(TIDX(wv)), wid = __builtin_amdgcn_readfirstlane(tid >> 6), lane = tid & 63, wr = wid >> 2, wc = wid & 3, fr = lane & 15, fq = lane >> 4;
    const int K = g.K, nt = K / BK;
    int RA0, CA0; stage_rc(tid * 16, RA0, CA0);
    const unsigned voffB0 = (unsigned)((Epi::PERM ? ((RA0 & ~31) + perm32(RA0 & 31)) : RA0) * g.ldb + CA0) * 2u;
    const size_t pstepB = (size_t)64 * g.ldb * 2;
    unsigned vA[2][2], nvA[2][2];
#define PG8_ROWOFF(dst, u_) do { _Pragma("unroll") for (int h_ = 0; h_ < 2; ++h_) _Pragma("unroll") for (int i_ = 0; i_ < 2; ++i_) \
        dst[h_][i_] = (unsigned)(S.arow(u_, h_ * HALF + RA0 + 64 * i_) * g.lda + CA0) * 2u; } while (0)
    const size_t kstep = (size_t)(BK * 2);
    const size_t hstepB = (size_t)HALF * g.ldb * 2;
    const size_t tstepB = 2 * hstepB;
    const unsigned ldsw = (unsigned)wid * 1024u;
    const int aoff = lds_byte(wr * 64 + fr, fq * 8), boff = lds_byte(wc * 32 + fr, fq * 8);
#define PG8_SA(b, h) (((b) * 2 + (h)) * HTB)
#define PG8_SB(b, h) ((4 + (b) * 2 + (h)) * HTB)
#define PG8_STAGE(bufoff, gbase, voff) do { _Pragma("unroll") for (int _i = 0; _i < 2; ++_i) \
        __builtin_amdgcn_global_load_lds((const unsigned*)((const char*)(gbase) + (voff)[_i]), (PG8_LAS unsigned*)(lds + (bufoff) + ldsw + _i * 8192), 16, 0, 0); } while (0)
#define PG8_STAGEB(bufoff, gbase) do { _Pragma("unroll") for (int _i = 0; _i < 2; ++_i) \
        __builtin_amdgcn_global_load_lds((const unsigned*)((const char*)(gbase) + _i * pstepB + voffB0), (PG8_LAS unsigned*)(lds + (bufoff) + ldsw + _i * 8192), 16, 0, 0); } while (0)
#define PG8_LDA(dst, b, h) do { _Pragma("unroll") for (int m = 0; m < 4; ++m) _Pragma("unroll") for (int k = 0; k < 2; ++k) dst[m][k] = *(const PG8_LAS bf16x8*)(lds + PG8_SA(b, h) + aoff + m * 2048 + k * 1024); } while (0)
#define PG8_LDB(dst, b, h) do { _Pragma("unroll") for (int n = 0; n < 2; ++n) _Pragma("unroll") for (int k = 0; k < 2; ++k) dst[n][k] = *(const PG8_LAS bf16x8*)(lds + PG8_SB(b, h) + boff + n * 2048 + k * 1024); } while (0)
#define PG8_MMA(ai, bj, At, Bt) do { __builtin_amdgcn_s_setprio(1); _Pragma("unroll") for (int m = 0; m < 4; ++m) _Pragma("unroll") for (int n = 0; n < 2; ++n) _Pragma("unroll") for (int k = 0; k < 2; ++k) \
        acc[ai][bj][m][n] = __builtin_amdgcn_mfma_f32_16x16x32_bf16(Bt[n][k], At[m][k], acc[ai][bj][m][n], 0, 0, 0); __builtin_amdgcn_s_setprio(0); } while (0)
#define PG8_WAIT_V(n) asm volatile("s_waitcnt vmcnt(" #n ")" ::: "memory")
#define PG8_WAIT_L(n) asm volatile("s_waitcnt lgkmcnt(" #n ")" ::: "memory")
#define PG8_BAR __builtin_amdgcn_s_barrier()
#define PG8_SCHED __builtin_amdgcn_sched_barrier(0)
    Unit cur, nxt; int ui = 0;
    if (!S.next(0, cur)) return;
    f32x4 acc[2][2][4][2];
#pragma unroll
    for (int a = 0; a < 2; ++a)
#pragma unroll
        for (int b = 0; b < 2; ++b)
#pragma unroll
            for (int m = 0; m < 4; ++m)
#pragma unroll
                for (int n = 0; n < 2; ++n) acc[a][b][m][n] = (f32x4){0.f, 0.f, 0.f, 0.f};
    bf16x8 At[4][2], B0[2][2], B1[2][2];
    const char* cA = (const char*)g.A; PG8_ROWOFF(vA, cur); const char* cB = (const char*)g.Bt + (size_t)cur.e * g.bstride * 2 + (size_t)cur.pn * tstepB;
    S.a_ready(cur);
    PG8_STAGEB(PG8_SB(0, 0), cB); PG8_STAGE(PG8_SA(0, 0), cA, vA[0]); PG8_STAGEB(PG8_SB(0, 1), cB + hstepB); PG8_STAGE(PG8_SA(0, 1), cA, vA[1]);
    if (wr == 1) PG8_BAR;
    PG8_WAIT_V(4); PG8_BAR;
    PG8_STAGEB(PG8_SB(1, 0), cB + kstep); PG8_STAGE(PG8_SA(1, 0), cA + kstep, vA[0]); PG8_STAGEB(PG8_SB(1, 1), cB + hstepB + kstep);
    PG8_WAIT_V(6); PG8_BAR;
    for (;;) {
        const bool has_next = S.next(ui + 1, nxt);
        if (has_next) PG8_ROWOFF(nvA, nxt); else { nvA[0][0] = vA[0][0]; nvA[0][1] = vA[0][1]; nvA[1][0] = vA[1][0]; nvA[1][1] = vA[1][1]; }
        const char* nB = has_next ? (const char*)g.Bt + (size_t)nxt.e * g.bstride * 2 + (size_t)nxt.pn * tstepB : cB;
        for (int t = 0; t < nt; t += 2) {
            const bool last = (t == nt - 2);
            const char* a1 = cA + (size_t)(t + 1) * kstep;
            const char* a2 = last ? cA : cA + (size_t)(t + 2) * kstep; const char* b2 = last ? nB : cB + (size_t)(t + 2) * kstep;
            const char* a3 = a2 + kstep; const char* b3 = b2 + kstep;
            if (last && has_next) S.a_ready(nxt);
            PG8_LDB(B0, 0, 0); PG8_SCHED; PG8_LDA(At, 0, 0); PG8_STAGE(PG8_SA(1, 1), a1, vA[1]);
            PG8_WAIT_L(8); PG8_BAR; PG8_WAIT_L(0); PG8_MMA(0, 0, At, B0); PG8_BAR; PG8_SCHED;
            PG8_LDB(B1, 0, 1); PG8_STAGEB(PG8_SB(0, 0), b2);
            PG8_BAR; PG8_WAIT_L(0); PG8_MMA(0, 1, At, B1); PG8_BAR;
            PG8_LDA(At, 0, 1); if (last) PG8_STAGE(PG8_SA(0, 0), a2, nvA[0]); else PG8_STAGE(PG8_SA(0, 0), a2, vA[0]);
            PG8_BAR; PG8_WAIT_L(0); PG8_MMA(1, 0, At, B0); PG8_BAR; PG8_SCHED;
            PG8_STAGEB(PG8_SB(0, 1), b2 + hstepB);
            PG8_WAIT_V(6); PG8_BAR; PG8_MMA(1, 1, At, B1); PG8_BAR;
            PG8_LDB(B0, 1, 0); PG8_SCHED; PG8_LDA(At, 1, 0); if (last) PG8_STAGE(PG8_SA(0, 1), a2, nvA[1]); else PG8_STAGE(PG8_SA(0, 1), a2, vA[1]);
            PG8_WAIT_L(8); PG8_BAR; PG8_WAIT_L(0); PG8_MMA(0, 0, At, B0); PG8_BAR; PG8_SCHED;
            PG8_LDB(B1, 1, 1); PG8_STAGEB(PG8_SB(1, 0), b3);
            PG8_BAR; PG8_WAIT_L(0); PG8_MMA(0, 1, At, B1); PG8_BAR;
            PG8_LDA(At, 1, 1); if (last) PG8_STAGE(PG8_SA(1, 0), a3, nvA[0]); else PG8_STAGE(PG8_SA(1, 0), a3, vA[0]);
            PG8_BAR; PG8_WAIT_L(0); PG8_MMA(1, 0, At, B0); PG8_BAR; PG8_SCHED;
            PG8_STAGEB(PG8_SB(1, 1), b3 + hstepB);
            PG8_WAIT_V(6); PG8_BAR; PG8_MMA(1, 1, At, B1); PG8_BAR;
        }
        { const int l2_ = TIDX(wv) & 63; E(acc, cur, wr, wc, l2_ & 15, l2_ >> 4); } S.done(cur);
        if (!has_next) break;
#pragma unroll
        for (int a = 0; a < 2; ++a)
#pragma unroll
            for (int b = 0; b < 2; ++b)
#pragma unroll
                for (int m = 0; m < 4; ++m)
#pragma unroll
                    for (int n = 0; n < 2; ++n) acc[a][b][m][n] = (f32x4){0.f, 0.f, 0.f, 0.f};
        cur = nxt; cB = nB; ++ui; vA[0][0] = nvA[0][0]; vA[0][1] = nvA[0][1]; vA[1][0] = nvA[1][0]; vA[1][1] = nvA[1][1];
    }
    PG8_WAIT_V(0);
    if (wr == 0) PG8_BAR;
    PG8_BAR;
#undef PG8_ROWOFF
#undef PG8_SA
#undef PG8_SB
#undef PG8_STAGE
#undef PG8_STAGEB
#undef PG8_LDA
#undef PG8_LDB
#undef PG8_MMA
#undef PG8_WAIT_V
#undef PG8_WAIT_L
#undef PG8_BAR
#undef PG8_SCHED
}

struct GatedMerge { const bf16_t* A; const bf16_t* Bt; const bf16_t* G; int ldg; bf16_t* Mg; int M; };
__device__ __forceinline__ void gemm_gated_phase(PG8_LAS unsigned char* lds, const GatedMerge g, int G_, int c_, int wv) {
    const int tid = opq(TIDX(wv)), wid = __builtin_amdgcn_readfirstlane(tid >> 6), lane = tid & 63, wr = wid >> 2, wc = wid & 3, fr = lane & 15, fq = lane >> 4;
    constexpr int K = 1024, nt = K / BK, NT = 8;
    const int nM = g.M / BM, nunits = nM * NT;
    unsigned voffA[2], voffB[2];
#pragma unroll
    for (int i = 0; i < 2; ++i) { int R, C; stage_rc(tid * 16 + i * 8192, R, C); const int Rb = (R & ~31) + perm32(R & 31);
        voffA[i] = (unsigned)(R * K + C) * 2u; voffB[i] = (unsigned)(Rb * K + C) * 2u; }
    const size_t kstep = (size_t)(BK * 2), hstepA = (size_t)HALF * K * 2, tstepA = 2 * hstepA, tstepB = (size_t)HALF * K * 2;
    const unsigned ldsw = (unsigned)wid * 1024u;
    const int aoff = lds_byte(wr * 64 + fr, fq * 8), boff = lds_byte(wc * 32 + fr, fq * 8);
#define PG8_SA(b, h) (((b) * 2 + (h)) * HTB)
#define PG8_SB(b, h) ((4 + (b) * 2 + (h)) * HTB)
#define PG8_STAGE(bufoff, gbase, voff) do { _Pragma("unroll") for (int _i = 0; _i < 2; ++_i) \
        __builtin_amdgcn_global_load_lds((const unsigned*)((const char*)(gbase) + (voff)[_i]), (PG8_LAS unsigned*)(lds + (bufoff) + ldsw + _i * 8192), 16, 0, 0); } while (0)
#define PG8_LDA(dst, b, h) do { _Pragma("unroll") for (int m = 0; m < 4; ++m) _Pragma("unroll") for (int k = 0; k < 2; ++k) dst[m][k] = *(const PG8_LAS bf16x8*)(lds + PG8_SA(b, h) + aoff + m * 2048 + k * 1024); } while (0)
#define PG8_LDB(dst, b, h) do { _Pragma("unroll") for (int n = 0; n < 2; ++n) _Pragma("unroll") for (int k = 0; k < 2; ++k) dst[n][k] = *(const PG8_LAS bf16x8*)(lds + PG8_SB(b, h) + boff + n * 2048 + k * 1024); } while (0)
#define PG8_MMA(ai, At, Bt) do { __builtin_amdgcn_s_setprio(1); _Pragma("unroll") for (int m = 0; m < 4; ++m) _Pragma("unroll") for (int n = 0; n < 2; ++n) _Pragma("unroll") for (int k = 0; k < 2; ++k) \
        acc[ai][m][n] = __builtin_amdgcn_mfma_f32_16x16x32_bf16(Bt[n][k], At[m][k], acc[ai][m][n], 0, 0, 0); __builtin_amdgcn_s_setprio(0); } while (0)
#define PG8_WAIT_V(n) asm volatile("s_waitcnt vmcnt(" #n ")" ::: "memory")
#define PG8_WAIT_L(n) asm volatile("s_waitcnt lgkmcnt(" #n ")" ::: "memory")
#define PG8_BAR __builtin_amdgcn_s_barrier()
#define PG8_SCHED __builtin_amdgcn_sched_barrier(0)
    int ui = 0; long L = c_;
    if (L >= nunits) return;
    int pm = (int)(L / NT), pn = (int)(L % NT);
    f32x4 acc[2][4][2], tot[2][4][2];
#pragma unroll
    for (int a = 0; a < 2; ++a)
#pragma unroll
        for (int m = 0; m < 4; ++m)
#pragma unroll
            for (int n = 0; n < 2; ++n) { acc[a][m][n] = (f32x4){0.f, 0.f, 0.f, 0.f}; tot[a][m][n] = (f32x4){0.f, 0.f, 0.f, 0.f}; }
    bf16x8 At[4][2], B0[2][2];
    u32x4 gq0[4], gq1[4];
    const char* cA = (const char*)g.A + (size_t)pm * tstepA; const char* cB = (const char*)g.Bt + (size_t)pn * tstepB;
#define GM_GOFF(z_) ((unsigned)(((pm * BM + wr * 64 + fr) * NPAD + (z_) * 1024 + pn * HALF + wc * 32 + 8 * fq) * 2))
#define GM_GLOAD0(z_) do { const unsigned go_ = GM_GOFF(z_); _Pragma("unroll") for (int m = 0; m < 4; ++m) gq0[m] = *(const u32x4*)((const char*)g.G + (go_ + (unsigned)((m * 16) * NPAD * 2))); } while (0)
#define GM_GLOAD1(z_) do { const unsigned go_ = GM_GOFF(z_); _Pragma("unroll") for (int m = 0; m < 4; ++m) gq1[m] = *(const u32x4*)((const char*)g.G + (go_ + (unsigned)((HALF + m * 16) * NPAD * 2))); } while (0)
    PG8_STAGE(PG8_SB(0, 0), cB, voffB); PG8_STAGE(PG8_SA(0, 0), cA, voffA); PG8_STAGE(PG8_SA(0, 1), cA + hstepA, voffA);
    if (wr == 1) PG8_BAR;
    PG8_WAIT_V(2); PG8_BAR;
    PG8_STAGE(PG8_SB(1, 0), cB + kstep, voffB); PG8_STAGE(PG8_SA(1, 0), cA + kstep, voffA);
    PG8_WAIT_V(4); PG8_BAR;
    GM_GLOAD0(0);
    for (;;) {
        const long Ln = (long)(ui + 1) * G_ + c_; const bool has_next = Ln < nunits;
        const int npm = has_next ? (int)(Ln / NT) : pm, npn = has_next ? (int)(Ln % NT) : pn;
        const char* nA = (const char*)g.A + (size_t)npm * tstepA; const char* nB = (const char*)g.Bt + (size_t)npn * tstepB;
        for (int t = 0; t < nt; t += 2) {
            const bool last = (t == nt - 2);
            const char* a1 = cA + (size_t)(t + 1) * kstep;
            const char* a2 = last ? nA : cA + (size_t)(t + 2) * kstep; const char* b2 = last ? nB : cB + (size_t)(t + 2) * kstep;
            const char* a3 = a2 + kstep; const char* b3 = b2 + kstep;
            PG8_LDB(B0, 0, 0); PG8_SCHED; PG8_LDA(At, 0, 0); PG8_STAGE(PG8_SA(1, 1), a1 + hstepA, voffA);
            PG8_WAIT_L(8); PG8_BAR; PG8_WAIT_L(0); PG8_MMA(0, At, B0); PG8_BAR; PG8_SCHED;
            PG8_STAGE(PG8_SB(0, 0), b2, voffB);
            PG8_BAR; PG8_BAR;
            PG8_LDA(At, 0, 1); PG8_STAGE(PG8_SA(0, 0), a2, voffA);
            PG8_BAR; PG8_WAIT_L(0); PG8_MMA(1, At, B0); PG8_BAR; PG8_SCHED;
            PG8_WAIT_V(4); PG8_BAR; PG8_BAR;
            PG8_LDB(B0, 1, 0); PG8_SCHED; PG8_LDA(At, 1, 0); PG8_STAGE(PG8_SA(0, 1), a2 + hstepA, voffA);
            PG8_WAIT_L(8); PG8_BAR; PG8_WAIT_L(0); PG8_MMA(0, At, B0); PG8_BAR; PG8_SCHED;
            PG8_STAGE(PG8_SB(1, 0), b3, voffB);
            PG8_BAR; PG8_BAR;
            PG8_LDA(At, 1, 1); PG8_STAGE(PG8_SA(1, 0), a3, voffA);
            PG8_BAR; PG8_WAIT_L(0); PG8_MMA(1, At, B0); PG8_BAR; PG8_SCHED;
            PG8_WAIT_V(4); PG8_BAR; PG8_BAR;
            if ((t & 2) != 0) {
                const int z = t >> 2;
                GM_GLOAD1(z);
#pragma unroll
                for (int ai = 0; ai < 2; ++ai)
#pragma unroll
                    for (int m = 0; m < 4; ++m) { float gv[8]; unpack8(ai ? gq1[m] : gq0[m], gv);
#pragma unroll
                        for (int j = 0; j < 4; ++j) { tot[ai][m][0][j] += sigm_fast(gv[j]) * acc[ai][m][0][j]; tot[ai][m][1][j] += sigm_fast(gv[4 + j]) * acc[ai][m][1][j]; }
                        acc[ai][m][0] = (f32x4){0.f, 0.f, 0.f, 0.f}; acc[ai][m][1] = (f32x4){0.f, 0.f, 0.f, 0.f}; }
                if (z < 3) { GM_GLOAD0(z + 1); }
                else {
                    const unsigned oo = (unsigned)(((pm * BM + wr * 64 + fr) * 1024 + pn * HALF + wc * 32 + 8 * fq) * 2);
#pragma unroll
                    for (int ai = 0; ai < 2; ++ai)
#pragma unroll
                        for (int m = 0; m < 4; ++m) { const f32x4 v0 = tot[ai][m][0], v1 = tot[ai][m][1];
                            u32x4 w; w.x = cvt_pk_bf16(v0[0], v0[1]); w.y = cvt_pk_bf16(v0[2], v0[3]); w.z = cvt_pk_bf16(v1[0], v1[1]); w.w = cvt_pk_bf16(v1[2], v1[3]);
                            *(u32x4*)((char*)g.Mg + (oo + (unsigned)((ai * HALF + m * 16) * 1024 * 2))) = w;
                            tot[ai][m][0] = (f32x4){0.f, 0.f, 0.f, 0.f}; tot[ai][m][1] = (f32x4){0.f, 0.f, 0.f, 0.f}; }
                    if (has_next) { pm = npm; pn = npn; GM_GLOAD0(0); }
                }
            }
        }
        if (!has_next) break;
        cA = nA; cB = nB; ++ui;
    }
    PG8_WAIT_V(0);
    if (wr == 0) PG8_BAR;
    PG8_BAR;
#undef GM_GLOAD0
#undef GM_GLOAD1
#undef GM_GOFF
#undef PG8_SA
#undef PG8_SB
#undef PG8_STAGE
#undef PG8_LDA
#undef PG8_LDB
#undef PG8_MMA
#undef PG8_WAIT_V
#undef PG8_WAIT_L
#undef PG8_BAR
#undef PG8_SCHED
}
}

__device__ __forceinline__ void ph_init(const Params& p, float* lds, int bid, int nb, int wv) {
    const int tid = opq(TIDX(wv)), lane = tid & 63, wave = tid >> 6;
    if (bid == 0) {
        float* rt = (float*)(p.ws + WS_WT + 512 * 1024);
        for (int i = tid; i < 1024; i += NTHR) { const int pos = i >> 4, f = i & 15;
            const double inv = (double)powf(10000.f, -(float)f / 16.f); const float ang = (float)pos * (float)inv;
            rt[i] = (float)cos((double)ang); rt[1024 + i] = (float)sin((double)ang); }
    }
    float* sc = lds;
    float* red = lds + 17 * 1024;
    if (bid < 384) {
        {   float cv_[34];
#pragma unroll
            for (int j = 0; j < 34; ++j) { const int i = tid + j * NTHR, b = i >> 10, k = i & 1023; cv_[j] = b < 16 ? p.in[I_C][b * 1024 + k] : p.in[I_CCTX][k]; }
            __builtin_amdgcn_sched_barrier(0);
#pragma unroll
            for (int j = 0; j < 34; ++j) sc[tid + j * NTHR] = silu_f(cv_[j]); }
        __syncthreads();
    }
    float* mod = (float*)(p.ws + WS_MOD);
    for (int it = bid; it < 384; it += nb) {
        const int l = it / 96, cg = it % 96, col = cg * 64 + lane;
        const float* w = p.in[I_WADA] + (size_t)l * D * 6144;
        float acc[17];
#pragma unroll
        for (int b = 0; b < 17; ++b) acc[b] = 0.f;
        for (int k0 = wave * 128; k0 < wave * 128 + 128; k0 += 32) { float wv_[32];
#pragma unroll
            for (int i = 0; i < 32; ++i) wv_[i] = w[(size_t)(k0 + i) * 6144 + col];
            __builtin_amdgcn_sched_barrier(0);
#pragma unroll
            for (int i = 0; i < 32; ++i)
#pragma unroll
                for (int b = 0; b < 17; ++b) acc[b] += sc[b * 1024 + k0 + i] * wv_[i];
            __builtin_amdgcn_sched_barrier(0); }
#pragma unroll
        for (int b = 0; b < 17; ++b) red[(wave * 17 + b) * 64 + lane] = acc[b];
        __syncthreads();
        for (int i = tid; i < 17 * 64; i += NTHR) { const int b = i >> 6, c = i & 63; float s = 0.f;
#pragma unroll
            for (int w8 = 0; w8 < 8; ++w8) s += red[(w8 * 17 + b) * 64 + c];
            mod[((size_t)l * 17 + b) * 6144 + cg * 64 + c] = s + p.in[I_BADA][l * 6144 + cg * 64 + c]; }
        __syncthreads();
    }
}

__device__ __forceinline__ void wconv_item(const float* W, int ldw, int N, bf16_t* WT, int ldt, int k0, int n0, int row_out0, float* scr, int lane) {
    const int nn = lane & 31; const bool ok = n0 + nn < N;
    float wv_[32];
#pragma unroll
    for (int i = 0; i < 32; ++i) { const int kk = 2 * i + (lane >> 5); wv_[i] = ok ? W[(size_t)(k0 + kk) * ldw + n0 + nn] : 0.f; }
#pragma unroll
    for (int i = 0; i < 32; ++i) { const int kk = 2 * i + (lane >> 5); scr[kk * 33 + nn] = wv_[i]; }
    asm volatile("s_waitcnt lgkmcnt(0)" ::: "memory"); __builtin_amdgcn_wave_barrier();
    const int c = lane & 7;
#pragma unroll
    for (int j = 0; j < 4; ++j) { const int n = (lane >> 3) + 8 * j; const float* s = scr + (8 * c) * 33 + n;
        u32x4 o; o.x = pk2(s[0 * 33], s[1 * 33]); o.y = pk2(s[2 * 33], s[3 * 33]); o.z = pk2(s[4 * 33], s[5 * 33]); o.w = pk2(s[6 * 33], s[7 * 33]);
        *(u32x4*)(WT + (size_t)(row_out0 + n) * ldt + k0 + 8 * c) = o; }
    asm volatile("s_waitcnt lgkmcnt(0)" ::: "memory"); __builtin_amdgcn_wave_barrier();
}
constexpr int WI0 = 16 * 226, WI1 = WI0 + 512, WI2 = WI1 + 512, WI3 = WI2 + 8192, WI4 = WI3 + 8192, WI5 = WI4 + 8192;
__device__ __forceinline__ void wconv_wave_item(const Params& p, int l, int it, float* scr, int lane) {
    unsigned char* wb = p.ws + WS_W;
    if (it < WI0) { const int kb = it / 226, nbk = it % 226;
        wconv_item(p.in[I_WIN] + (size_t)l * D * INW, INW, INW, (bf16_t*)(wb + W_IN), 1024, kb * 64, nbk * 32, nbk * 32, scr, lane); }
    else if (it < WI1) { const int r = it - WI0, z = r >> 7, kb = (r & 127) >> 5, nbk = r & 31;
        wconv_item(p.in[I_WBR] + ((size_t)l * 4 + z) * 256 * D, D, D, (bf16_t*)(wb + W_BR) + (size_t)z * 256, 1024, kb * 64, nbk * 32, nbk * 32, scr, lane); }
    else if (it < WI2) { const int r = it - WI1, kb = r >> 5, nbk = r & 31;
        wconv_item(p.in[I_WOUT] + (size_t)l * D * D, D, D, (bf16_t*)(wb + W_OUT), 1024, kb * 64, nbk * 32, nbk * 32, scr, lane); }
    else if (it < WI4) { const int up = it >= WI3, r = it - (up ? WI3 : WI2), e = r >> 8, kb = (r & 255) >> 4, nbk = r & 15, n0 = nbk * 32;
        wconv_item((up ? p.in[I_WUP] : p.in[I_WGATE]) + ((size_t)l * NEXP + e) * D * EH, EH, EH, (bf16_t*)(wb + W_GU) + (size_t)e * 1024 * 1024, 1024, kb * 64, n0,
                   (n0 >> 7) * 256 + (n0 & 127) + up * 128, scr, lane); }
    else { const int r = it - WI4, e = r >> 8, kb = (r & 255) >> 5, nbk = r & 31;
        wconv_item(p.in[I_WDOWN] + ((size_t)l * NEXP + e) * EH * D, D, D, (bf16_t*)(wb + W_DN) + (size_t)e * 1024 * 512, 512, kb * 64, nbk * 32, nbk * 32, scr, lane); }
}
__device__ __forceinline__ void router_relayout(const Params& p, int l, int tid) {
    float* RE = (float*)(p.ws + WS_W + W_RE); float* RG = (float*)(p.ws + WS_W + W_RG);
    const float* wre = p.in[I_WRE] + (size_t)l * 4 * D * 8; const float* wrg = p.in[I_WRG] + (size_t)l * D * 4;
    for (int i = tid; i < 4 * 1024 * 8 + 1024 * 4; i += NTHR) {
        if (i < 32768) { const int k = i & 7, ln = (i >> 3) & 63, e = (i >> 9) & 3, j = (i >> 11) & 3, g = i >> 13; RE[i] = wre[((size_t)g * D + j * 256 + ln * 4 + e) * 8 + k]; }
        else { const int i2 = i - 32768, g = i2 & 3, ln = (i2 >> 2) & 63, e = (i2 >> 8) & 3, j = i2 >> 10; RG[i2] = wrg[(size_t)(j * 256 + ln * 4 + e) * 4 + g]; } }
}
__device__ __forceinline__ void ph_wconv_mod(const Params& p, int l, float* lds, int bid, int nb, int wv) {
    const int tid = opq(TIDX(wv)), lane = tid & 63, wave = tid >> 6;
    const int gw = bid * 8 + wave, NGW = nb * 8;
    float* scr = lds + wave * 2112;
    if (l == 0) for (int it = gw; it < WI0; it += NGW) wconv_wave_item(p, 0, it, scr, lane);
    const float* mod = (const float*)(p.ws + WS_MOD) + (size_t)l * 17 * 6144;
    bf16_t* H = (bf16_t*)(p.ws + WS_H);
    for (int r = gw; r < TT; r += NGW) {
        const float* xr = xin_row(p, r); const float* m = mod + (size_t)brow(r) * 6144;
#pragma unroll
        for (int j = 0; j < 4; ++j) { const int c = j * 256 + lane * 4; const f32x4 xv = *(const f32x4*)(xr + c), s1 = *(const f32x4*)(m + 1024 + c), sh = *(const f32x4*)(m + c);
            u32x2 o; o.x = pk2(xv[0] * (1.f + s1[0]) + sh[0], xv[1] * (1.f + s1[1]) + sh[1]); o.y = pk2(xv[2] * (1.f + s1[2]) + sh[2], xv[3] * (1.f + s1[3]) + sh[3]);
            *(u32x2*)(H + (size_t)r * D + c) = o;
            sth4((_Float16*)p.out + (size_t)r * D + c, xv); }
    }
}

__device__ __forceinline__ void ph_prep(const Params& p, int l, int bid, int nb, int wv, int dry = 0) {
    const int tid = opq(TIDX(wv)), lane = tid & 63, wave = tid >> 6;
    bf16_t* P = (bf16_t*)(p.ws + WS_P);
    bf16_t* CQ = (bf16_t*)(p.ws + WS_X + X_CQ);
    _Float16* LA = (_Float16*)(p.ws + WS_X + X_LA);
    float* GB = (float*)(p.ws + WS_GB);
    const float* rt = (const float*)(p.ws + WS_WT + 512 * 1024);
    const float* qg = p.in[I_AQG] + l * 64; const float* kg = p.in[I_AKG] + l * 64;
    const float* cw = p.in[I_CCONV] + (size_t)l * 3 * 768;
    float gwr[4][16], gbr[4];
    { const float* gw = p.in[I_DGW] + (size_t)l * 2 * 16 * 128; const float* gb = p.in[I_DGB] + l * 256;
#pragma unroll
        for (int q4 = 0; q4 < 4; ++q4) { const int idx = q4 * 64 + lane, zz = idx >> 7, k = idx & 127; gbr[q4] = gb[zz * 128 + k];
#pragma unroll
            for (int rr = 0; rr < 16; ++rr) gwr[q4][rr] = gw[(zz * 16 + rr) * 128 + k]; } }
    const int l16 = lane & 15, hsel = lane >> 4;
    const f32x4 qg4 = *(const f32x4*)(qg + 4 * l16) * (0.125f * 1.4426950408889634f), kg4 = *(const f32x4*)(kg + 4 * l16);
    f32x4 cwr[3][3];
#pragma unroll
    for (int j = 0; j < 3; ++j)
#pragma unroll
        for (int t = 0; t < 3; ++t) cwr[j][t] = *(const f32x4*)(cw + t * 768 + j * 256 + 4 * lane);
    for (int r = bid * 8 + wave; r < TT; r += nb * 8) {
        bf16_t* pr = P + (size_t)r * NPAD;
        const bool lat = r < TL;
        {
            const int t = r & 2047, gr = t >> 6, gc = t & 63;
            const int pos = (l16 >> 3) ? gc : gr;
            const f32x4 cs = *(const f32x4*)(rt + pos * 16 + 4 * (l16 & 3)), sn = *(const f32x4*)(rt + 1024 + pos * 16 + 4 * (l16 & 3));
            const bool first = (l16 & 4) == 0;
            const u32x2 wq = *(const u32x2*)(pr + 4 * lane), wk = *(const u32x2*)(pr + 256 + 4 * (lane & 31));
#pragma unroll
            for (int part = 0; part < 2; ++part) { const u32x2 w = part ? wk : wq; const f32x4 gn = part ? kg4 : qg4;
                float v[4] = {bflo(w.x), bfhi(w.x), bflo(w.y), bfhi(w.y)};
                float ss = (v[0] * v[0] + v[1] * v[1]) + (v[2] * v[2] + v[3] * v[3]);
                ss = row16_sum(ss);
                const float rn = rsqrtf(ss * (1.f / 64.f) + EPS); float y[4], yp[4];
#pragma unroll
                for (int e = 0; e < 4; ++e) y[e] = v[e] * rn * gn[e];
#pragma unroll
                for (int e = 0; e < 4; ++e) yp[e] = shx<4>(y[e]);
                if (lat) {
#pragma unroll
                    for (int e = 0; e < 4; ++e) y[e] = first ? (y[e] * cs[e] - yp[e] * sn[e]) : (yp[e] * sn[e] + y[e] * cs[e]); }
                u32x2 o; o.x = pk2(y[0], y[1]); o.y = pk2(y[2], y[3]);
                bf16_t* dst = (dry ? (bf16_t*)(p.ws + WS_CM) + (size_t)(r & 4095) * NPAD : pr) + (part ? 256 + 4 * (lane & 31) : 4 * lane);
                if (part == 0 || lane < 32) *(u32x2*)dst = o; }
        }
        {
            const int pos = lat ? (r & 2047) : ((r - TL) & 255); const int n = lat ? 2048 : 256;
            const bool hp = pos > 0, hn = pos < n - 1;
            u32x2 x0[3], x1[3], x2[3];
#pragma unroll
            for (int j = 0; j < 3; ++j) { const bf16_t* xp = pr + C_CQKV + j * 256 + 4 * lane;
                x1[j] = *(const u32x2*)xp; x0[j] = hp ? *(const u32x2*)(xp - NPAD) : (u32x2){0u, 0u}; x2[j] = hn ? *(const u32x2*)(xp + NPAD) : (u32x2){0u, 0u}; }
#pragma unroll
            for (int j = 0; j < 3; ++j) { const int ch = j * 256 + 4 * lane;
                const f32x4 w0 = cwr[j][0], w1 = cwr[j][1], w2 = cwr[j][2];
                const float a0[4] = {bflo(x0[j].x), bfhi(x0[j].x), bflo(x0[j].y), bfhi(x0[j].y)}, a1[4] = {bflo(x1[j].x), bfhi(x1[j].x), bflo(x1[j].y), bfhi(x1[j].y)}, a2[4] = {bflo(x2[j].x), bfhi(x2[j].x), bflo(x2[j].y), bfhi(x2[j].y)};
                float v[4];
#pragma unroll
                for (int e = 0; e < 4; ++e) v[e] = silu_f(a0[e] * w0[e] + a1[e] * w1[e] + a2[e] * w2[e]);
                if (j < 2) { float ss = (v[0] * v[0] + v[1] * v[1]) + (v[2] * v[2] + v[3] * v[3]);
                    ss = row16_sum(ss);
                    const float rn = rsqrtf(ss + EPS) * (j == 0 ? 0.125f : 1.f);
#pragma unroll
                    for (int e = 0; e < 4; ++e) v[e] *= rn; }
                u32x2 o; o.x = pk2(v[0], v[1]); o.y = pk2(v[2], v[3]);
                *(u32x2*)((dry ? (bf16_t*)(p.ws + WS_CL) : CQ) + (size_t)r * 768 + ch) = o; }
            if (lane < 8) { const int dir = lane >> 2, h = lane & 3;
                const float be = sigm_f(bf2f(pr[C_CBETA + lane]));
                const float a = bf2f(pr[C_CA + lane]);
                const float la = -expf(p.in[I_CALOG][l * 8 + dir * 4 + h]) * softplus_f(a + p.in[I_CDTB][l * 8 + dir * 4 + h]);
                float* GBw = dry ? (float*)(p.ws + WS_DL) : GB; GBw[(size_t)r * 16 + lane] = be; GBw[(size_t)r * 16 + 8 + lane] = la; }
        }
        {
            const float lrv = bf2f(pr[C_DLR + (lane & 31)]);
#pragma unroll
            for (int q4 = 0; q4 < 4; ++q4) { const int zz = q4 >> 1;
                float z = gbr[q4];
#pragma unroll
                for (int rr = 0; rr < 16; ++rr) z += __int_as_float(__builtin_amdgcn_readlane(__float_as_int(lrv), zz * 16 + rr)) * gwr[q4][rr];
                const float ls = fminf(z, 0.f) - __logf(1.f + __expf(-fabsf(z)));
                (dry ? (_Float16*)(p.ws + WS_CL) + (size_t)TT * 768 : LA)[(size_t)r * 256 + q4 * 64 + lane] = (_Float16)(ls * (1.f / 16.f)); }
        }
    }
}

typedef float f32x16 __attribute__((ext_vector_type(16)));
constexpr int ATT_KP = 72, ATT_VP = 96, ATT_VOFF = 64 * ATT_KP * 2, ATT_BUF = ATT_VOFF + 64 * ATT_VP * 2;
typedef short v4i16_t __attribute__((ext_vector_type(4)));
__device__ __forceinline__ u32x2 vtr_read(const LAS unsigned char* a) { return __builtin_bit_cast(u32x2, __builtin_amdgcn_ds_read_tr16_b64_v4i16((LAS v4i16_t*)a)); }
__device__ __forceinline__ int vtr_base(int lane) { return ((4 * (lane >> 5) + ((lane >> 2) & 3)) * ATT_VP + 16 * ((lane >> 4) & 1) + 4 * (lane & 3)) * 2; }
template <bool QS>
__device__ __forceinline__ void attn_mfma_unit(const Params& p, LAS unsigned char* lds, int qrow_w, int qcol_w, int ocol_w, int kcol, int vcol,
                                               int kb0, int kn0, int kb1, int kn1, int wv) {
    const int tid = opq(TIDX(wv)), lane = tid & 63, r = lane & 31, h = lane >> 5;
    const bf16_t* P = (const bf16_t*)(p.ws + WS_P); bf16_t* O = (bf16_t*)(p.ws + WS_O);
    constexpr float C = 0.125f * 1.4426950408889634f;
    bf16x8 qf[4];
    { const bf16_t* qp = P + (size_t)(qrow_w + r) * NPAD + qcol_w + 8 * h;
#pragma unroll
        for (int s = 0; s < 4; ++s) qf[s] = *(const bf16x8*)(qp + 16 * s); }
    f32x16 ot0, ot1;
#pragma unroll
    for (int i = 0; i < 16; ++i) { ot0[i] = 0.f; ot1[i] = 0.f; }
    float m = QS ? 0.f : -1e30f, lsum = 0.f;
    f32x16 negm;
#pragma unroll
    for (int i = 0; i < 16; ++i) negm[i] = 0.f;
    const int ntile = (kn0 + kn1) >> 6, nt0 = kn0 >> 6;
    const int lkey = tid >> 3, lc8 = tid & 7;
    u32x4 kreg, vreg;
    { const bf16_t* src = P + (size_t)((0 < nt0 ? kb0 : kb1) + lkey) * NPAD; kreg = *(const u32x4*)(src + kcol + lc8 * 8); vreg = *(const u32x4*)(src + vcol + lc8 * 8); }
    __syncthreads();
    for (int t = 0; t < ntile; ++t) {
        LAS unsigned char* buf = lds + (t & 1) * ATT_BUF;
        {
            *(LAS u32x4*)(buf + (lkey * ATT_KP + lc8 * 8) * 2) = kreg;
            *(LAS u32x4*)(buf + ATT_VOFF + (lkey * ATT_VP + lc8 * 8) * 2) = vreg;
        }
        if (t + 1 < ntile) { const int tn = t + 1; const int row = (tn < nt0 ? kb0 + tn * 64 : kb1 + (tn - nt0) * 64) + lkey;
            const bf16_t* src = P + (size_t)row * NPAD; kreg = *(const u32x4*)(src + kcol + lc8 * 8); vreg = *(const u32x4*)(src + vcol + lc8 * 8); }
        __syncthreads();
        f32x16 x0, x1;
        const LAS unsigned char* kp0 = buf + (r * ATT_KP + 8 * h) * 2;
        const LAS unsigned char* vp0 = buf + ATT_VOFF + vtr_base(lane);
        {
            bf16x8 ka[4], kb[4];
#pragma unroll
            for (int s = 0; s < 4; ++s) { ka[s] = *(const LAS bf16x8*)(kp0 + s * 32); kb[s] = *(const LAS bf16x8*)(kp0 + 32 * ATT_KP * 2 + s * 32); }
            __builtin_amdgcn_sched_barrier(0);
            x0 = __builtin_amdgcn_mfma_f32_32x32x16_bf16(ka[0], qf[0], negm, 0, 0, 0); x1 = __builtin_amdgcn_mfma_f32_32x32x16_bf16(kb[0], qf[0], negm, 0, 0, 0);
#pragma unroll
            for (int s = 1; s < 4; ++s) { x0 = __builtin_amdgcn_mfma_f32_32x32x16_bf16(ka[s], qf[s], x0, 0, 0, 0); x1 = __builtin_amdgcn_mfma_f32_32x32x16_bf16(kb[s], qf[s], x1, 0, 0, 0); }
        }
        u32x2 vfa[4][2], vfb[4][2];
#pragma unroll
        for (int ks = 0; ks < 4; ++ks) { const int ko = 16 * ks * ATT_VP * 2;
            vfa[ks][0] = vtr_read(vp0 + ko); vfa[ks][1] = vtr_read(vp0 + ko + 8 * ATT_VP * 2);
            vfb[ks][0] = vtr_read(vp0 + ko + 64); vfb[ks][1] = vtr_read(vp0 + ko + 8 * ATT_VP * 2 + 64); }
        __builtin_amdgcn_sched_barrier(0);
        float mx = x0[0];
#pragma unroll
        for (int i = 1; i < 16; ++i) mx = fmaxf(mx, x0[i]);
#pragma unroll
        for (int i = 0; i < 16; ++i) mx = fmaxf(mx, x1[i]);
        { auto rr = __builtin_amdgcn_permlane32_swap(__float_as_uint(mx), __float_as_uint(mx), false, false); mx = fmaxf(__uint_as_float(rr[0]), __uint_as_float(rr[1])); }
        float ps = 0.f;
        if (QS) {
            const bool grow = (t == 0) || (mx > 8.f);
            if (__any(grow)) {
                const float d = grow ? mx : 0.f; m += d;
                const float corr = (t == 0) ? 1.f : __builtin_amdgcn_exp2f(-d); lsum *= corr;
#pragma unroll
                for (int i = 0; i < 16; ++i) { ot0[i] *= corr; ot1[i] *= corr; x0[i] -= d; x1[i] -= d; negm[i] = -m; } }
#pragma unroll
            for (int i = 0; i < 16; ++i) { x0[i] = __builtin_amdgcn_exp2f(x0[i]); x1[i] = __builtin_amdgcn_exp2f(x1[i]); ps += x0[i] + x1[i]; }
        } else {
            const float mn = fmaxf(m, mx * C);
            if (__any(mn > m)) {
                const float corr = __builtin_amdgcn_exp2f(m - mn); m = mn; lsum *= corr;
#pragma unroll
                for (int i = 0; i < 16; ++i) { ot0[i] *= corr; ot1[i] *= corr; } }
#pragma unroll
            for (int i = 0; i < 16; ++i) { x0[i] = __builtin_amdgcn_exp2f(fmaf(x0[i], C, -m)); x1[i] = __builtin_amdgcn_exp2f(fmaf(x1[i], C, -m)); ps += x0[i] + x1[i]; }
        }
        lsum += ps;
#pragma unroll
        for (int kt = 0; kt < 2; ++kt) {
#pragma unroll
            for (int s = 0; s < 2; ++s) {
                const f32x16& x = kt ? x1 : x0;
                u32x4 pw; pw.x = pg8::cvt_pk_bf16(x[8 * s], x[8 * s + 1]); pw.y = pg8::cvt_pk_bf16(x[8 * s + 2], x[8 * s + 3]);
                pw.z = pg8::cvt_pk_bf16(x[8 * s + 4], x[8 * s + 5]); pw.w = pg8::cvt_pk_bf16(x[8 * s + 6], x[8 * s + 7]);
                const bf16x8 pb = __builtin_bit_cast(bf16x8, pw);
                const int ks = kt * 2 + s;
                const u32x4 va = (u32x4){vfa[ks][0].x, vfa[ks][0].y, vfa[ks][1].x, vfa[ks][1].y}, vb = (u32x4){vfb[ks][0].x, vfb[ks][0].y, vfb[ks][1].x, vfb[ks][1].y};
                ot0 = __builtin_amdgcn_mfma_f32_32x32x16_bf16(__builtin_bit_cast(bf16x8, va), pb, ot0, 0, 0, 0);
                ot1 = __builtin_amdgcn_mfma_f32_32x32x16_bf16(__builtin_bit_cast(bf16x8, vb), pb, ot1, 0, 0, 0);
            }
        }
    }
    { auto rr = __builtin_amdgcn_permlane32_swap(__float_as_uint(lsum), __float_as_uint(lsum), false, false); lsum = __uint_as_float(rr[0]) + __uint_as_float(rr[1]); }
    const float inv = 1.f / lsum;
    bf16_t* op = O + (size_t)(qrow_w + r) * D + ocol_w + 4 * h;
#pragma unroll
    for (int i = 0; i < 4; ++i) {
        u32x2 w0, w1;
        w0.x = pg8::cvt_pk_bf16(ot0[4 * i] * inv, ot0[4 * i + 1] * inv); w0.y = pg8::cvt_pk_bf16(ot0[4 * i + 2] * inv, ot0[4 * i + 3] * inv);
        w1.x = pg8::cvt_pk_bf16(ot1[4 * i] * inv, ot1[4 * i + 1] * inv); w1.y = pg8::cvt_pk_bf16(ot1[4 * i + 2] * inv, ot1[4 * i + 3] * inv);
        *(u32x2*)(op + 8 * i) = w0; *(u32x2*)(op + 32 + 8 * i) = w1;
    }
}
__device__ __forceinline__ void attn_na_unit(const Params& p, LAS unsigned char* lds, int l, int b, int hd, int rg, int wv) {
    const int tid = opq(TIDX(wv)), lane = tid & 63, r = lane & 31, h = lane >> 5, wave = tid >> 6;
    const bf16_t* P = (const bf16_t*)(p.ws + WS_P); bf16_t* O = (bf16_t*)(p.ws + WS_O);
    constexpr float C = 0.125f * 1.4426950408889634f;
    const int gr = rg * 4 + (wave >> 1), qc = (wave & 1) * 32 + r, cs = min(max(qc - 8, 0), 48), rs = min(max(gr - 4, 0), 24);
    const int u0 = min(max(rg * 4 - 4, 0), 24), u1 = min(max(rg * 4 - 1, 0), 24) + 8, nloc = u1 - u0, ntile = nloc + 4;
    const int qrow = b * 2048 + gr * 64 + qc;
    LAS float* tb = (LAS float*)(lds + 2 * ATT_BUF);
    __syncthreads();
    { const float* rpb = p.in[I_RPB] + (size_t)(l * 4 + hd) * 15 * 31;
        if (tid < 480) tb[tid] = (tid & 31) < 31 ? rpb[(tid >> 5) * 31 + (tid & 31)] * 1.4426950408889634f : 0.f; }
    bf16x8 qf[4];
    { const bf16_t* qp = P + (size_t)qrow * NPAD + C_BQ + hd * 64 + 8 * h;
#pragma unroll
        for (int s = 0; s < 4; ++s) qf[s] = *(const bf16x8*)(qp + 16 * s); }
    f32x16 ot0, ot1;
#pragma unroll
    for (int i = 0; i < 16; ++i) { ot0[i] = 0.f; ot1[i] = 0.f; }
    float m = -1e30f, lsum = 0.f;
    const int lkey = tid >> 3, lc8 = tid & 7;
    const int kcol = C_BK + hd * 64, vcol = C_BV + hd * 64;
    u32x4 kreg, vreg;
    { const bf16_t* src = P + (size_t)(b * 2048 + u0 * 64 + lkey) * NPAD; kreg = *(const u32x4*)(src + kcol + lc8 * 8); vreg = *(const u32x4*)(src + vcol + lc8 * 8); }
    for (int t = 0; t < ntile; ++t) {
        LAS unsigned char* buf = lds + (t & 1) * ATT_BUF;
        {
            *(LAS u32x4*)(buf + (lkey * ATT_KP + lc8 * 8) * 2) = kreg;
            *(LAS u32x4*)(buf + ATT_VOFF + (lkey * ATT_VP + lc8 * 8) * 2) = vreg;
        }
        if (t + 1 < ntile) { const int tn = t + 1; const int row = (tn < nloc ? b * 2048 + (u0 + tn) * 64 : TL + b * 256 + (tn - nloc) * 64) + lkey;
            const bf16_t* src = P + (size_t)row * NPAD; kreg = *(const u32x4*)(src + kcol + lc8 * 8); vreg = *(const u32x4*)(src + vcol + lc8 * 8); }
        __syncthreads();
        const bool loc = t < nloc; const int kr = u0 + t;
        if (!loc || (kr >= rs && kr < rs + 8)) {
            f32x16 x0, x1;
#pragma unroll
            for (int i = 0; i < 16; ++i) { x0[i] = 0.f; x1[i] = 0.f; }
            const LAS unsigned char* kp0 = buf + (r * ATT_KP + 8 * h) * 2;
            const LAS unsigned char* vp0 = buf + ATT_VOFF + vtr_base(lane);
            {
                bf16x8 ka[4], kb[4];
#pragma unroll
                for (int s = 0; s < 4; ++s) { ka[s] = *(const LAS bf16x8*)(kp0 + s * 32); kb[s] = *(const LAS bf16x8*)(kp0 + 32 * ATT_KP * 2 + s * 32); }
                __builtin_amdgcn_sched_barrier(0);
#pragma unroll
                for (int s = 0; s < 4; ++s) { x0 = __builtin_amdgcn_mfma_f32_32x32x16_bf16(ka[s], qf[s], x0, 0, 0, 0); x1 = __builtin_amdgcn_mfma_f32_32x32x16_bf16(kb[s], qf[s], x1, 0, 0, 0); }
            }
            u32x2 vfa[4][2], vfb[4][2];
#pragma unroll
            for (int ks = 0; ks < 4; ++ks) { const int ko = 16 * ks * ATT_VP * 2;
                vfa[ks][0] = vtr_read(vp0 + ko); vfa[ks][1] = vtr_read(vp0 + ko + 8 * ATT_VP * 2);
                vfb[ks][0] = vtr_read(vp0 + ko + 64); vfb[ks][1] = vtr_read(vp0 + ko + 8 * ATT_VP * 2 + 64); }
            __builtin_amdgcn_sched_barrier(0);
            if (loc) {
                const LAS float* trow = tb + (kr - gr + 7) * 32;
#pragma unroll
                for (int i = 0; i < 16; ++i) {
                    const int kc0 = (i & 3) + 8 * (i >> 2) + 4 * h, kc1 = kc0 + 32;
                    const int d0 = kc0 - cs, d1 = kc1 - cs;
                    const float b0 = trow[min(max(kc0 - qc + 15, 0), 30)], b1 = trow[min(max(kc1 - qc + 15, 0), 30)];
                    x0[i] = (d0 >= 0 && d0 < 16) ? fmaf(x0[i], C, b0) : -1e30f;
                    x1[i] = (d1 >= 0 && d1 < 16) ? fmaf(x1[i], C, b1) : -1e30f;
                }
            } else {
#pragma unroll
                for (int i = 0; i < 16; ++i) { x0[i] *= C; x1[i] *= C; }
            }
            float mx = x0[0];
#pragma unroll
            for (int i = 1; i < 16; ++i) mx = fmaxf(mx, x0[i]);
#pragma unroll
            for (int i = 0; i < 16; ++i) mx = fmaxf(mx, x1[i]);
            { auto rr = __builtin_amdgcn_permlane32_swap(__float_as_uint(mx), __float_as_uint(mx), false, false); mx = fmaxf(__uint_as_float(rr[0]), __uint_as_float(rr[1])); }
            const bool grow = (m < -1e29f) || (mx > m + 8.f);
            if (__any(grow)) { const float mn = grow ? mx : m; const float corr = __builtin_amdgcn_exp2f(m - mn); m = mn; lsum *= corr;
#pragma unroll
                for (int i = 0; i < 16; ++i) { ot0[i] *= corr; ot1[i] *= corr; } }
            float ps = 0.f;
#pragma unroll
            for (int i = 0; i < 16; ++i) { x0[i] = __builtin_amdgcn_exp2f(x0[i] - m); x1[i] = __builtin_amdgcn_exp2f(x1[i] - m); ps += x0[i] + x1[i]; }
            lsum += ps;
#pragma unroll
            for (int kt = 0; kt < 2; ++kt) {
#pragma unroll
                for (int s = 0; s < 2; ++s) {
                    const f32x16& x = kt ? x1 : x0;
                    u32x4 pw; pw.x = pg8::cvt_pk_bf16(x[8 * s], x[8 * s + 1]); pw.y = pg8::cvt_pk_bf16(x[8 * s + 2], x[8 * s + 3]);
                    pw.z = pg8::cvt_pk_bf16(x[8 * s + 4], x[8 * s + 5]); pw.w = pg8::cvt_pk_bf16(x[8 * s + 6], x[8 * s + 7]);
                    const bf16x8 pb = __builtin_bit_cast(bf16x8, pw);
                    const int ks = kt * 2 + s;
                    const u32x4 va = (u32x4){vfa[ks][0].x, vfa[ks][0].y, vfa[ks][1].x, vfa[ks][1].y}, vb = (u32x4){vfb[ks][0].x, vfb[ks][0].y, vfb[ks][1].x, vfb[ks][1].y};
                    ot0 = __builtin_amdgcn_mfma_f32_32x32x16_bf16(__builtin_bit_cast(bf16x8, va), pb, ot0, 0, 0, 0);
                    ot1 = __builtin_amdgcn_mfma_f32_32x32x16_bf16(__builtin_bit_cast(bf16x8, vb), pb, ot1, 0, 0, 0);
                }
            }
        }
    }
    { auto rr = __builtin_amdgcn_permlane32_swap(__float_as_uint(lsum), __float_as_uint(lsum), false, false); lsum = __uint_as_float(rr[0]) + __uint_as_float(rr[1]); }
    const float inv = 1.f / lsum;
    bf16_t* op = O + (size_t)qrow * D + 256 + hd * 64 + 4 * h;
#pragma unroll
    for (int i = 0; i < 4; ++i) {
        u32x2 w0, w1;
        w0.x = pg8::cvt_pk_bf16(ot0[4 * i] * inv, ot0[4 * i + 1] * inv); w0.y = pg8::cvt_pk_bf16(ot0[4 * i + 2] * inv, ot0[4 * i + 3] * inv);
        w1.x = pg8::cvt_pk_bf16(ot1[4 * i] * inv, ot1[4 * i + 1] * inv); w1.y = pg8::cvt_pk_bf16(ot1[4 * i + 2] * inv, ot1[4 * i + 3] * inv);
        *(u32x2*)(op + 8 * i) = w0; *(u32x2*)(op + 32 + 8 * i) = w1;
    }
}
__device__ __forceinline__ void chunk_rows(int b, int dir, int c, int& rb, int& n, int& cc) { const int seg = c >= 4; cc = seg ? c - 4 : c; n = seg ? 2048 : 256; rb = seg ? b * 2048 : TL + b * 256; }
__device__ __forceinline__ int opqd(int v, float dep) { asm volatile("" : "+v"(v) : "v"(dep)); return v; }
__device__ __forceinline__ int crow(int reg, int hh) { return (reg & 3) + 8 * (reg >> 2) + 4 * hh; }
#define WY_FRAG(X, s, f0, f1) do { \
    const unsigned pa0_ = pg8::cvt_pk_bf16(X[16 * (s) + 0], X[16 * (s) + 1]), pa1_ = pg8::cvt_pk_bf16(X[16 * (s) + 2], X[16 * (s) + 3]), pa2_ = pg8::cvt_pk_bf16(X[16 * (s) + 8], X[16 * (s) + 9]), pa3_ = pg8::cvt_pk_bf16(X[16 * (s) + 10], X[16 * (s) + 11]); \
    const unsigned pb0_ = pg8::cvt_pk_bf16(X[16 * (s) + 4], X[16 * (s) + 5]), pb1_ = pg8::cvt_pk_bf16(X[16 * (s) + 6], X[16 * (s) + 7]), pb2_ = pg8::cvt_pk_bf16(X[16 * (s) + 12], X[16 * (s) + 13]), pb3_ = pg8::cvt_pk_bf16(X[16 * (s) + 14], X[16 * (s) + 15]); \
    const auto r0_ = __builtin_amdgcn_permlane32_swap(pa0_, pb0_, false, false); const auto r1_ = __builtin_amdgcn_permlane32_swap(pa1_, pb1_, false, false); \
    const auto r2_ = __builtin_amdgcn_permlane32_swap(pa2_, pb2_, false, false); const auto r3_ = __builtin_amdgcn_permlane32_swap(pa3_, pb3_, false, false); \
    f0 = __builtin_bit_cast(bf16x8, (u32x4){r0_[0], r1_[0], r2_[0], r3_[0]}); f1 = __builtin_bit_cast(bf16x8, (u32x4){r0_[1], r1_[1], r2_[1], r3_[1]}); } while (0)
__device__ __forceinline__ bf16x8 acc_frag(const f32x16& x, int s) {
    u32x4 w; w.x = pg8::cvt_pk_bf16(x[8 * s], x[8 * s + 1]); w.y = pg8::cvt_pk_bf16(x[8 * s + 2], x[8 * s + 3]); w.z = pg8::cvt_pk_bf16(x[8 * s + 4], x[8 * s + 5]); w.w = pg8::cvt_pk_bf16(x[8 * s + 6], x[8 * s + 7]);
    return __builtin_bit_cast(bf16x8, w); }
constexpr int WY_LDS = 17408;
__device__ __forceinline__ void wyC_pass1(const Params& p, int task, LAS unsigned char* wl, int lane_) {
    const int lane = opq(lane_);
    const int c = task % 36, chain = task / 36, dir = chain & 1, h = (chain >> 1) & 3, b = chain >> 3, r = lane & 31, hh = lane >> 5;
    int rb, n, cc; chunk_rows(b, dir, c, rb, n, cc);
    const bf16_t* CQ = (const bf16_t*)(p.ws + WS_X + X_CQ); const float* GB = (const float*)(p.ws + WS_GB);
    float* CM = (float*)(p.ws + WS_CM) + (size_t)task * 4096; float* CL = (float*)(p.ws + WS_CL) + (size_t)task * 4096;
    bf16_t* QE = (bf16_t*)(p.ws + WS_H + 36 * MiB) + (size_t)task * 4096;
    bf16_t* Od = (bf16_t*)(p.ws + WS_X + X_OC) + (size_t)dir * TT * 256;
    LAS float* Ls = (LAS float*)wl; LAS float* tbe = Ls + 4096; LAS float* tg = tbe + 64; LAS float* teg = tg + 64; LAS float* tla = teg + 64;
#define WY_ROW(i_) ((size_t)(rb + (dir ? n - 1 - (cc * 64 + (i_)) : cc * 64 + (i_))))
    const size_t myrow = WY_ROW(lane);
    const float be_l = GB[myrow * 16 + dir * 4 + h], la_l = GB[myrow * 16 + 8 + dir * 4 + h];
    bf16x8 kf[2][4];
#pragma unroll
    for (int t = 0; t < 2; ++t) { const bf16_t* kp = CQ + WY_ROW(t * 32 + r) * 768 + 256 + h * 64 + 8 * hh;
#pragma unroll
        for (int s = 0; s < 4; ++s) kf[t][s] = *(const bf16x8*)(kp + 16 * s); }
    tla[lane] = la_l; tbe[lane] = be_l;
    asm volatile("s_waitcnt lgkmcnt(0)" ::: "memory"); __builtin_amdgcn_wave_barrier();
    float g_l = 0.f, gtot = 0.f;
#pragma unroll
    for (int t8 = 0; t8 < 2; ++t8) { f32x4 xq[8];
#pragma unroll
        for (int t4 = 0; t4 < 8; ++t4) xq[t4] = *(const LAS f32x4*)(tla + 32 * t8 + 4 * t4);
        __builtin_amdgcn_sched_barrier(0);
#pragma unroll
        for (int t4 = 0; t4 < 8; ++t4)
#pragma unroll
            for (int e = 0; e < 4; ++e) { g_l += (32 * t8 + 4 * t4 + e <= lane) ? xq[t4][e] : 0.f; gtot += xq[t4][e]; }
        __builtin_amdgcn_sched_barrier(0); }
    tg[lane] = g_l; teg[lane] = __expf(g_l);
    asm volatile("s_waitcnt lgkmcnt(0)" ::: "memory"); __builtin_amdgcn_wave_barrier();
    const float egtot = __expf(gtot);
    float l21t[16];
    {
        {
            f32x16 a;
#pragma unroll
            for (int i = 0; i < 16; ++i) a[i] = 0.f;
#pragma unroll
            for (int s = 0; s < 4; ++s) a = __builtin_amdgcn_mfma_f32_32x32x16_bf16(kf[0][s], kf[1][s], a, 0, 0, 0);
            const float gi = tg[32 + r], bi = tbe[32 + r];
#pragma unroll
            for (int q = 0; q < 4; ++q) { const f32x4 gj = *(const LAS f32x4*)(tg + 8 * q + 4 * hh);
#pragma unroll
                for (int e = 0; e < 4; ++e) l21t[4 * q + e] = bi * a[4 * q + e] * __expf(gi - gj[e]); }
        }
#pragma unroll
        for (int tile = 0; tile < 2; ++tile) { const int it = tile, jt = tile;
            f32x16 a;
#pragma unroll
            for (int i = 0; i < 16; ++i) a[i] = 0.f;
#pragma unroll
            for (int s = 0; s < 4; ++s) a = __builtin_amdgcn_mfma_f32_32x32x16_bf16(kf[it][s], kf[jt][s], a, 0, 0, 0);
            const int j = jt * 32 + r; const float gj = tg[j];
#pragma unroll
            for (int q = 0; q < 4; ++q) { const f32x4 gi = *(const LAS f32x4*)(tg + it * 32 + 8 * q + 4 * hh), bi = *(const LAS f32x4*)(tbe + it * 32 + 8 * q + 4 * hh);
#pragma unroll
                for (int e = 0; e < 4; ++e) { const int i = it * 32 + 8 * q + 4 * hh + e;
                    Ls[i * 64 + j] = (j < i) ? bi[e] * a[4 * q + e] * __expf(gi[e] - gj) : 0.f; } }
        }
    }
    asm volatile("s_waitcnt lgkmcnt(0)" ::: "memory"); __builtin_amdgcn_wave_barrier();
    bf16x8 Wp[4][2], Up[4][2]; float dep = egtot;
#pragma unroll 1
    for (int which = 0; which < 2; ++which) {
        float x[64]; const int lane = opqd(lane_, dep);
        const long rstep = dir ? -768 : 768;
        const bf16_t* rp = CQ + WY_ROW(0) * 768 + 256 + which * 256 + h * 64;
        const float cw = tbe[lane] * (which ? 1.f : teg[lane]);
        { bf16_t xraw[64];
#pragma unroll
          for (int i = 0; i < 64; ++i) { xraw[i] = rp[lane]; rp += rstep; }
          __builtin_amdgcn_sched_barrier(0);
#pragma unroll
          for (int i = 0; i < 64; ++i) x[i] = __int_as_float(__builtin_amdgcn_readlane(__float_as_int(cw), i)) * bf2f(xraw[i]); }
#pragma unroll
        for (int i = 1; i < 32; ++i) { f32x4 lv[8];
#pragma unroll
            for (int j4 = 0; j4 < (i + 3) / 4; ++j4) lv[j4] = *(const LAS f32x4*)(Ls + i * 64 + 4 * j4);
            __builtin_amdgcn_sched_barrier(0);
#pragma unroll
            for (int j4 = 0; j4 < (i + 3) / 4; ++j4)
#pragma unroll
                for (int e = 0; e < 4; ++e) if (4 * j4 + e < i) x[i] -= lv[j4][e] * x[4 * j4 + e];
            __builtin_amdgcn_sched_barrier(0); }
        {
            f32x16 d0, d1;
#pragma unroll
            for (int i = 0; i < 16; ++i) { d0[i] = 0.f; d1[i] = 0.f; }
#pragma unroll
            for (int s = 0; s < 16; ++s) { const int j0 = (s & 3) + 8 * (s >> 2);
                const auto bb = __builtin_amdgcn_permlane32_swap(__float_as_uint(x[j0]), __float_as_uint(x[j0 + 4]), false, false);
                d0 = __builtin_amdgcn_mfma_f32_32x32x2f32(l21t[s], __uint_as_float(bb[0]), d0, 0, 0, 0);
                d1 = __builtin_amdgcn_mfma_f32_32x32x2f32(l21t[s], __uint_as_float(bb[1]), d1, 0, 0, 0); }
#pragma unroll
            for (int t = 0; t < 16; ++t) { const int i0 = 32 + (t & 3) + 8 * (t >> 2);
                const auto dd = __builtin_amdgcn_permlane32_swap(__float_as_uint(d0[t]), __float_as_uint(d1[t]), false, false);
                x[i0] -= __uint_as_float(dd[0]); x[i0 + 4] -= __uint_as_float(dd[1]); }
        }
#pragma unroll
        for (int i = 33; i < 64; ++i) { f32x4 lv[8];
#pragma unroll
            for (int j4 = 8; j4 < (i + 3) / 4; ++j4) lv[j4 - 8] = *(const LAS f32x4*)(Ls + i * 64 + 4 * j4);
            __builtin_amdgcn_sched_barrier(0);
#pragma unroll
            for (int j4 = 8; j4 < (i + 3) / 4; ++j4)
#pragma unroll
                for (int e = 0; e < 4; ++e) if (4 * j4 + e < i) x[i] -= lv[j4 - 8][e] * x[4 * j4 + e];
            __builtin_amdgcn_sched_barrier(0); }
        dep = x[63];
        if (which == 0) {
#pragma unroll
            for (int s = 0; s < 4; ++s) WY_FRAG(x, s, Wp[s][0], Wp[s][1]); }
        else {
#pragma unroll
            for (int s = 0; s < 4; ++s) WY_FRAG(x, s, Up[s][0], Up[s][1]); }
    }
    __builtin_amdgcn_sched_barrier(0);
    {
        const int lane = opqd(lane_, dep), r = lane & 31, hh = lane >> 5;
        bf16x8 Kp[4][2];
        { const long rstep = dir ? -768 : 768; const bf16_t* rp = CQ + WY_ROW(0) * 768 + 256 + h * 64;
            bf16_t kraw[64];
#pragma unroll
            for (int i = 0; i < 64; ++i) { kraw[i] = rp[lane]; rp += rstep; }
            __builtin_amdgcn_sched_barrier(0);
#pragma unroll
            for (int s = 0; s < 4; ++s) { float kg[16];
#pragma unroll
                for (int ii = 0; ii < 16; ++ii) kg[ii] = bf2f(kraw[16 * s + ii]) * __expf(gtot - tg[16 * s + ii]);
                WY_FRAG(kg, 0, Kp[s][0], Kp[s][1]);
                __builtin_amdgcn_sched_barrier(0); } }
#pragma unroll
        for (int which = 0; which < 2; ++which)
#pragma unroll
            for (int rt = 0; rt < 2; ++rt)
#pragma unroll
                for (int ct = 0; ct < 2; ++ct) { f32x16 a;
#pragma unroll
                    for (int i = 0; i < 16; ++i) a[i] = 0.f;
#pragma unroll
                    for (int s = 0; s < 4; ++s) a = __builtin_amdgcn_mfma_f32_32x32x16_bf16(Kp[s][rt], which ? Up[s][ct] : Wp[s][ct], a, 0, 0, 0);
                    char* dst = (char*)(which ? CL : CM); const unsigned o0 = (unsigned)(((rt * 32 + 4 * hh) * 64 + ct * 32 + r) * 4);
#pragma unroll
                    for (int i = 0; i < 16; ++i) { const int dp = rt * 32 + crow(i, hh), dc = ct * 32 + r;
                        *(float*)(dst + (o0 + (unsigned)((((i & 3) + 8 * (i >> 2)) * 64) * 4))) = which ? a[i] : ((dp == dc ? egtot : 0.f) - a[i]); }
                    dep = a[15]; }
    }
    {
        const int lane = opqd(lane_, dep), r = lane & 31, hh = lane >> 5;
        f32x16 qk[3];
        u32x2 qwv[2][2][4];
        {
            bf16x8 kfG[2][4], qfG[2][4];
#pragma unroll
            for (int t2 = 0; t2 < 2; ++t2) { const bf16_t* kp = CQ + WY_ROW(t2 * 32 + r) * 768 + 256 + h * 64 + 8 * hh; const bf16_t* qp = CQ + WY_ROW(t2 * 32 + r) * 768 + h * 64 + 8 * hh;
#pragma unroll
                for (int s = 0; s < 4; ++s) { kfG[t2][s] = *(const bf16x8*)(kp + 16 * s); qfG[t2][s] = *(const bf16x8*)(qp + 16 * s); } }
            __builtin_amdgcn_sched_barrier(0);
#pragma unroll
            for (int it = 0; it < 2; ++it)
#pragma unroll
                for (int s = 0; s < 4; ++s) { const u32x4 w_ = __builtin_bit_cast(u32x4, qfG[it][s]);
                    const auto s0_ = __builtin_amdgcn_permlane32_swap(w_.x, w_.z, false, false); const auto s1_ = __builtin_amdgcn_permlane32_swap(w_.y, w_.w, false, false);
                    qwv[s >> 1][it][2 * (s & 1)] = (u32x2){s0_[0], s1_[0]}; qwv[s >> 1][it][2 * (s & 1) + 1] = (u32x2){s0_[1], s1_[1]}; }
#pragma unroll
            for (int tile = 0; tile < 3; ++tile) { const int jt = tile == 2, it = tile >= 1;
                f32x16 a;
#pragma unroll
                for (int i = 0; i < 16; ++i) a[i] = 0.f;
#pragma unroll
                for (int s = 0; s < 4; ++s) a = __builtin_amdgcn_mfma_f32_32x32x16_bf16(kfG[jt][s], qfG[it][s], a, 0, 0, 0);
                const int i = it * 32 + r; const float gi = tg[i];
#pragma unroll
                for (int q = 0; q < 4; ++q) { const f32x4 gj = *(const LAS f32x4*)(tg + jt * 32 + 8 * q + 4 * hh);
#pragma unroll
                    for (int e = 0; e < 4; ++e) { const int j = jt * 32 + 8 * q + 4 * hh + e; a[4 * q + e] = (j <= i) ? a[4 * q + e] * __expf(gi - gj[e]) : 0.f; } }
                qk[tile] = a; } }
        const int lane3 = opqd(lane_, qk[2][15]), r3 = lane3 & 31, hh3 = lane3 >> 5;
#pragma unroll
        for (int which = 0; which < 2; ++which)
#pragma unroll
            for (int dt = 0; dt < 2; ++dt)
#pragma unroll
                for (int it = 0; it < 2; ++it) { f32x16 a;
#pragma unroll
                    for (int i = 0; i < 16; ++i) a[i] = 0.f;
#pragma unroll
                    for (int jt = 0; jt <= it; ++jt) { const f32x16& x = (jt == 0) ? (it == 0 ? qk[0] : qk[1]) : qk[2];
#pragma unroll
                        for (int s2 = 0; s2 < 2; ++s2) a = __builtin_amdgcn_mfma_f32_32x32x16_bf16(which ? Up[2 * jt + s2][dt] : Wp[2 * jt + s2][dt], acc_frag(x, s2), a, 0, 0, 0); }
                    const int i = it * 32 + r3; const size_t ri = WY_ROW(i);
                    if (which == 0) { const float eg = teg[i];
#pragma unroll
                        for (int q = 0; q < 4; ++q) { const int d0 = dt * 32 + 8 * q + 4 * hh3; const u32x2 qw = qwv[dt][it][q];
                            u32x2 w; w.x = pg8::cvt_pk_bf16(bflo(qw.x) * eg - a[4 * q], bfhi(qw.x) * eg - a[4 * q + 1]); w.y = pg8::cvt_pk_bf16(bflo(qw.y) * eg - a[4 * q + 2], bfhi(qw.y) * eg - a[4 * q + 3]);
                            *(u32x2*)(QE + i * 64 + d0) = w; } }
                    else {
#pragma unroll
                        for (int q = 0; q < 4; ++q) { const int e0 = dt * 32 + 8 * q + 4 * hh3;
                            u32x2 w; w.x = pk2(a[4 * q], a[4 * q + 1]); w.y = pk2(a[4 * q + 2], a[4 * q + 3]);
                            *(u32x2*)(Od + ri * 256 + h * 64 + e0) = w; } }
                }
    }
    asm volatile("s_waitcnt lgkmcnt(0)" ::: "memory"); __builtin_amdgcn_wave_barrier();
}
__device__ __forceinline__ void wyC_pass3(const Params& p, int task, int lane_) {
    const int lane = opq(lane_);
    const int c = task % 36, chain = task / 36, dir = chain & 1, h = (chain >> 1) & 3, b = chain >> 3, r = lane & 31, hh = lane >> 5;
    int rb, n, cc; chunk_rows(b, dir, c, rb, n, cc);
    const bf16_t* SI = (const bf16_t*)((const char*)p.out + 72 * MiB) + (size_t)task * 4096;
    const bf16_t* QE = (const bf16_t*)(p.ws + WS_H + 36 * MiB) + (size_t)task * 4096;
    bf16_t* Od = (bf16_t*)(p.ws + WS_X + X_OC) + (size_t)dir * TT * 256;
    bf16x8 sf[2][4], qf[2][4];
#pragma unroll
    for (int t = 0; t < 2; ++t)
#pragma unroll
        for (int s = 0; s < 4; ++s) { unsigned v[8];
#pragma unroll
            for (int jj = 0; jj < 8; ++jj) v[jj] = SI[(16 * s + 8 * hh + jj) * 64 + t * 32 + r];
            u32x4 w; w.x = v[0] | (v[1] << 16); w.y = v[2] | (v[3] << 16); w.z = v[4] | (v[5] << 16); w.w = v[6] | (v[7] << 16);
            sf[t][s] = __builtin_bit_cast(bf16x8, w);
            qf[t][s] = *(const bf16x8*)(QE + (t * 32 + r) * 64 + 16 * s + 8 * hh); }
    u32x2 ow_[2][2][4];
#pragma unroll
    for (int et = 0; et < 2; ++et)
#pragma unroll
        for (int it = 0; it < 2; ++it) { const size_t ri = WY_ROW(it * 32 + r);
#pragma unroll
            for (int q = 0; q < 4; ++q) ow_[et][it][q] = *(const u32x2*)(Od + ri * 256 + h * 64 + et * 32 + 8 * q + 4 * hh); }
    __builtin_amdgcn_sched_barrier(0);
#pragma unroll
    for (int et = 0; et < 2; ++et)
#pragma unroll
        for (int it = 0; it < 2; ++it) { f32x16 a;
#pragma unroll
            for (int i = 0; i < 16; ++i) a[i] = 0.f;
#pragma unroll
            for (int s = 0; s < 4; ++s) a = __builtin_amdgcn_mfma_f32_32x32x16_bf16(sf[et][s], qf[it][s], a, 0, 0, 0);
            const int i = it * 32 + r; const size_t ri = WY_ROW(i);
#pragma unroll
            for (int q = 0; q < 4; ++q) { bf16_t* op = Od + ri * 256 + h * 64 + et * 32 + 8 * q + 4 * hh; const u32x2 ow = ow_[et][it][q];
                u32x2 w; w.x = pg8::cvt_pk_bf16(bflo(ow.x) + a[4 * q], bfhi(ow.x) + a[4 * q + 1]); w.y = pg8::cvt_pk_bf16(bflo(ow.y) + a[4 * q + 2], bfhi(ow.y) + a[4 * q + 3]);
                *(u32x2*)op = w; } }
#undef WY_ROW
}
__device__ __forceinline__ float gla_gtable(const _Float16* LA, LAS float* G, int rb, int n, int cc, int dir, int h, int lane) {
    const int d = lane & 31, half = lane >> 5;
    float acc = 0.f, gl[32];
#pragma unroll
    for (int jj = 0; jj < 32; ++jj) { const int i = cc * 64 + 32 * half + jj; const size_t r = (size_t)(rb + (dir ? n - 1 - i : i)); gl[jj] = (float)LA[r * 256 + dir * 128 + h * 32 + d]; }
#pragma unroll
    for (int jj = 0; jj < 32; ++jj) { acc += gl[jj]; gl[jj] = acc; }
    float tlo, thi; { auto rr = __builtin_amdgcn_permlane32_swap(__float_as_uint(acc), __float_as_uint(acc), false, false); tlo = __uint_as_float(rr[0]); thi = __uint_as_float(rr[1]); }
    const float add = half ? tlo : 0.f;
#pragma unroll
    for (int jj = 0; jj < 32; ++jj) G[(32 * half + jj) * 32 + d] = gl[jj] + add;
    asm volatile("s_waitcnt lgkmcnt(0)" ::: "memory"); __builtin_amdgcn_wave_barrier();
    return tlo + thi;
}
#define TILE_TR_LOAD(tq_, ROWPTR_) do { _Pragma("unroll") for (int i_ = 0; i_ < 8; ++i_) { const int key_ = 8 * i_ + (lane >> 3); tq_[i_] = *(const u32x4*)(ROWPTR_(key_) + 8 * (lane & 7)); } } while (0)
#define TILE_TR_FRAGS(img_, tq_, f_) do { \
        _Pragma("unroll") for (int i_ = 0; i_ < 8; ++i_) *(LAS u32x4*)((img_) + (8 * i_ + (lane >> 3)) * 144 + (lane & 7) * 16) = tq_[i_]; \
        asm volatile("s_waitcnt lgkmcnt(0)" ::: "memory"); __builtin_amdgcn_wave_barrier(); \
        const LAS unsigned char* vb_ = (img_) + ((4 * (lane >> 5) + ((lane >> 2) & 3)) * 72 + 16 * ((lane >> 4) & 1) + 4 * (lane & 3)) * 2; \
        _Pragma("unroll") for (int s_ = 0; s_ < 4; ++s_) { \
            const u32x2 a0_ = vtr_read(vb_ + 16 * s_ * 144), a1_ = vtr_read(vb_ + (16 * s_ + 8) * 144), b0_ = vtr_read(vb_ + 16 * s_ * 144 + 64), b1_ = vtr_read(vb_ + (16 * s_ + 8) * 144 + 64); \
            f_[s_][0] = __builtin_bit_cast(bf16x8, (u32x4){a0_.x, a0_.y, a1_.x, a1_.y}); f_[s_][1] = __builtin_bit_cast(bf16x8, (u32x4){b0_.x, b0_.y, b1_.x, b1_.y}); } } while (0)
__device__ __forceinline__ void glaD_pass1(const Params& p, int task, LAS unsigned char* wl, int lane_) {
    const int lane = opq(lane_);
    const int c = task % 36, chain = task / 36, dir = chain & 1, h = (chain >> 1) & 3, b = chain >> 3, r = lane & 31, hh = lane >> 5;
    int rb, n, cc; chunk_rows(b, dir, c, rb, n, cc);
    const bf16_t* P = (const bf16_t*)(p.ws + WS_P); const _Float16* LA = (const _Float16*)(p.ws + WS_X + X_LA);
    float* DL = (float*)(p.ws + WS_DL) + (size_t)task * 2048; float* DV = (float*)(p.ws + WS_DV) + (size_t)task * 32;
    LAS float* G = (LAS float*)wl;
#define GL_ROW(i_) ((size_t)(rb + (dir ? n - 1 - (cc * 64 + (i_)) : cc * 64 + (i_))))
#define GL_VROW(k_) (P + GL_ROW(k_) * NPAD + C_DV + h * 64)
    u32x4 vtq[8]; TILE_TR_LOAD(vtq, GL_VROW);
    bf16_t kraw[4][8];
#pragma unroll
    for (int s = 0; s < 4; ++s)
#pragma unroll
        for (int jj = 0; jj < 8; ++jj) { const int j = 16 * s + 8 * (jj >> 2) + 4 * hh + (jj & 3); kraw[s][jj] = P[GL_ROW(j) * NPAD + C_DK + h * 32 + r]; }
    const float gtot = gla_gtable(LA, G, rb, n, cc, dir, h, lane);
    if (lane < 32) DV[lane] = __expf(gtot);
    bf16x8 af[4];
    __builtin_amdgcn_sched_barrier(0);
#pragma unroll
    for (int s = 0; s < 4; ++s) { float kv[8];
#pragma unroll
        for (int jj = 0; jj < 8; ++jj) { const int j = 16 * s + 8 * (jj >> 2) + 4 * hh + (jj & 3); kv[jj] = bf2f(kraw[s][jj]) * __expf(gtot - G[j * 32 + r]); }
        u32x4 w; w.x = pk2(kv[0], kv[1]); w.y = pk2(kv[2], kv[3]); w.z = pk2(kv[4], kv[5]); w.w = pk2(kv[6], kv[7]); af[s] = __builtin_bit_cast(bf16x8, w); }
    bf16x8 bfr[4][2];
    TILE_TR_FRAGS(wl + 8192, vtq, bfr);
#pragma unroll
    for (int ct = 0; ct < 2; ++ct) { f32x16 a;
#pragma unroll
        for (int i = 0; i < 16; ++i) a[i] = 0.f;
#pragma unroll
        for (int s = 0; s < 4; ++s) a = __builtin_amdgcn_mfma_f32_32x32x16_bf16(af[s], bfr[s][ct], a, 0, 0, 0);
#pragma unroll
        for (int i = 0; i < 16; ++i) DL[crow(i, hh) * 64 + ct * 32 + r] = a[i]; }
    asm volatile("s_waitcnt lgkmcnt(0)" ::: "memory"); __builtin_amdgcn_wave_barrier();
}
__device__ __forceinline__ void glaD_pass3(const Params& p, int task, LAS unsigned char* wl, int lane_) {
    const int lane = opq(lane_);
    const int c = task % 36, chain = task / 36, dir = chain & 1, h = (chain >> 1) & 3, b = chain >> 3, r = lane & 31, hh = lane >> 5;
    int rb, n, cc; chunk_rows(b, dir, c, rb, n, cc);
    const bf16_t* P = (const bf16_t*)(p.ws + WS_P); const _Float16* LA = (const _Float16*)(p.ws + WS_X + X_LA);
    const bf16_t* SI = (const bf16_t*)((const char*)p.out + 108 * MiB) + (size_t)task * 2048;
    bf16_t* Od = (bf16_t*)(p.ws + WS_H) + (size_t)dir * TT * 256;
    LAS float* G = (LAS float*)wl;
    u32x4 qraw[2][2], kraw[2][2]; unsigned sraw[2][2][8];
#pragma unroll
    for (int t = 0; t < 2; ++t)
#pragma unroll
        for (int s = 0; s < 2; ++s) { const int row = t * 32 + r, d0 = 16 * s + 8 * hh; const size_t gr = GL_ROW(row);
            qraw[t][s] = *(const u32x4*)(P + gr * NPAD + C_DQ + h * 32 + d0); kraw[t][s] = *(const u32x4*)(P + gr * NPAD + C_DK + h * 32 + d0);
#pragma unroll
            for (int jj = 0; jj < 8; ++jj) sraw[t][s][jj] = SI[(d0 + jj) * 64 + t * 32 + r]; }
    u32x4 vtq[8]; TILE_TR_LOAD(vtq, GL_VROW);
    (void)gla_gtable(LA, G, rb, n, cc, dir, h, lane);
    const float qscale = 0.17677669529663687f;
    bf16x8 qf[2][2], kf[2][2], sf[2][2];
#pragma unroll
    for (int t = 0; t < 2; ++t)
#pragma unroll
        for (int s = 0; s < 2; ++s) { const int row = t * 32 + r, d0 = 16 * s + 8 * hh; const size_t gr = GL_ROW(row);
            float qv[8], kv[8], gv[8], sv[8];
            unpack8(qraw[t][s], qv); unpack8(kraw[t][s], kv); (void)gr;
            { const f32x4 g0 = *(const LAS f32x4*)(G + row * 32 + d0), g1 = *(const LAS f32x4*)(G + row * 32 + d0 + 4); gv[0] = g0[0]; gv[1] = g0[1]; gv[2] = g0[2]; gv[3] = g0[3]; gv[4] = g1[0]; gv[5] = g1[1]; gv[6] = g1[2]; gv[7] = g1[3]; }
#pragma unroll
            for (int jj = 0; jj < 8; ++jj) { qv[jj] = qv[jj] * qscale * __expf(gv[jj]); kv[jj] = kv[jj] * __expf(-gv[jj]); }
            u32x4 w; w.x = pk2(qv[0], qv[1]); w.y = pk2(qv[2], qv[3]); w.z = pk2(qv[4], qv[5]); w.w = pk2(qv[6], qv[7]); qf[t][s] = __builtin_bit_cast(bf16x8, w);
            w.x = pk2(kv[0], kv[1]); w.y = pk2(kv[2], kv[3]); w.z = pk2(kv[4], kv[5]); w.w = pk2(kv[6], kv[7]); kf[t][s] = __builtin_bit_cast(bf16x8, w);
            w.x = sraw[t][s][0] | (sraw[t][s][1] << 16); w.y = sraw[t][s][2] | (sraw[t][s][3] << 16); w.z = sraw[t][s][4] | (sraw[t][s][5] << 16); w.w = sraw[t][s][6] | (sraw[t][s][7] << 16); sf[t][s] = __builtin_bit_cast(bf16x8, w); }
    f32x16 at[3];
#pragma unroll
    for (int tile = 0; tile < 3; ++tile) { const int jt = tile == 2, it = tile >= 1; f32x16 a;
#pragma unroll
        for (int i = 0; i < 16; ++i) a[i] = 0.f;
#pragma unroll
        for (int s = 0; s < 2; ++s) a = __builtin_amdgcn_mfma_f32_32x32x16_bf16(kf[jt][s], qf[it][s], a, 0, 0, 0);
        const int i = it * 32 + r;
#pragma unroll
        for (int q = 0; q < 16; ++q) { const int j = jt * 32 + crow(q, hh); a[q] = (j <= i) ? a[q] * 1.0f : 0.f; }
        at[tile] = a; }
    bf16x8 vf[4][2];
    TILE_TR_FRAGS(wl + 8192, vtq, vf);
#pragma unroll
    for (int et = 0; et < 2; ++et)
#pragma unroll
        for (int it = 0; it < 2; ++it) { f32x16 a;
#pragma unroll
            for (int i = 0; i < 16; ++i) a[i] = 0.f;
#pragma unroll
            for (int s = 0; s < 2; ++s) a = __builtin_amdgcn_mfma_f32_32x32x16_bf16(sf[et][s], qf[it][s], a, 0, 0, 0);
#pragma unroll
            for (int jt = 0; jt <= it; ++jt) { const f32x16& x = (jt == 0) ? (it == 0 ? at[0] : at[1]) : at[2];
#pragma unroll
                for (int s2 = 0; s2 < 2; ++s2) { u32x4 w; w.x = pk2(x[8 * s2], x[8 * s2 + 1]); w.y = pk2(x[8 * s2 + 2], x[8 * s2 + 3]); w.z = pk2(x[8 * s2 + 4], x[8 * s2 + 5]); w.w = pk2(x[8 * s2 + 6], x[8 * s2 + 7]);
                    a = __builtin_amdgcn_mfma_f32_32x32x16_bf16(vf[2 * jt + s2][et], __builtin_bit_cast(bf16x8, w), a, 0, 0, 0); } }
            const size_t ri = GL_ROW(it * 32 + r);
#pragma unroll
            for (int q = 0; q < 4; ++q) { u32x2 w; w.x = pk2(a[4 * q], a[4 * q + 1]); w.y = pk2(a[4 * q + 2], a[4 * q + 3]);
                *(u32x2*)(Od + ri * 256 + h * 64 + et * 32 + 8 * q + 4 * hh) = w; } }
    asm volatile("s_waitcnt lgkmcnt(0)" ::: "memory"); __builtin_amdgcn_wave_barrier();
#undef GL_VROW
#undef GL_ROW
}
__device__ __forceinline__ void chainC_item(const Params& p, int chain, float* lds, int wv) {
    const int tid = opq(TIDX(wv)), lane = tid & 63, wave = tid >> 6;
    float* Ms = lds;
    float* Xs = lds + 4096;
    float Sr[64];
#pragma unroll
    for (int d = 0; d < 64; ++d) Sr[d] = 0.f;
    __syncthreads();
    { f32x4* x4 = (f32x4*)Xs + tid * 2; x4[0] = (f32x4){0.f, 0.f, 0.f, 0.f}; x4[1] = (f32x4){0.f, 0.f, 0.f, 0.f}; }
    const f32x4* CM0 = (const f32x4*)((const float*)(p.ws + WS_CM) + (size_t)chain * 36 * 4096) + tid * 2; f32x4* CL0 = (f32x4*)((float*)(p.ws + WS_CL) + (size_t)chain * 36 * 4096) + tid * 2;
    f32x4 m0 = CM0[0], m1 = CM0[1], l0 = CL0[0], l1 = CL0[1];
    for (int c = 0; c < 36; ++c) {
        __syncthreads();
        { f32x4* mdst = (f32x4*)Ms + tid * 2; f32x4* x4 = (f32x4*)Xs + tid * 2; f32x4* cl4 = CL0 + (size_t)c * 1024; const f32x4 e0 = x4[0], e1 = x4[1];
            (void)cl4;
            { u32x4 w_; w_.x = pk2(e0[0], e0[1]); w_.y = pk2(e0[2], e0[3]); w_.z = pk2(e1[0], e1[1]); w_.w = pk2(e1[2], e1[3]);
              *(u32x4*)((bf16_t*)((char*)p.out + 72 * MiB) + ((size_t)chain * 36 + c) * 4096 + tid * 8) = w_; }
            x4[0] = l0; x4[1] = l1; mdst[0] = m0; mdst[1] = m1; }
        if (c + 1 < 36) { const f32x4* cm = CM0 + (size_t)(c + 1) * 1024; const f32x4* cl = CL0 + (size_t)(c + 1) * 1024; m0 = cm[0]; m1 = cm[1]; l0 = cl[0]; l1 = cl[1]; }
        __syncthreads();
#pragma unroll 1
        for (int k = 0; k < 8; ++k) { const int row = wave * 8 + k; const float* mr = Ms + row * 64; float a0 = 0.f, a1 = 0.f;
#pragma unroll
            for (int d4 = 0; d4 < 16; d4 += 2) { const f32x4 q0 = *(const f32x4*)(mr + d4 * 4), q1 = *(const f32x4*)(mr + d4 * 4 + 4);
                a0 += q0[0] * Sr[d4 * 4] + q0[1] * Sr[d4 * 4 + 1] + q0[2] * Sr[d4 * 4 + 2] + q0[3] * Sr[d4 * 4 + 3];
                a1 += q1[0] * Sr[d4 * 4 + 4] + q1[1] * Sr[d4 * 4 + 5] + q1[2] * Sr[d4 * 4 + 6] + q1[3] * Sr[d4 * 4 + 7]; }
            Xs[row * 64 + lane] += a0 + a1; }
        __syncthreads();
#pragma unroll
        for (int d = 0; d < 64; ++d) Sr[d] = Xs[d * 64 + lane];
    }
    __syncthreads();
}
__device__ __forceinline__ void chainD_item(const Params& p, int chain, int wv) {
    const int tid = opq(TIDX(wv));
    f32x4 S = (f32x4){0.f, 0.f, 0.f, 0.f};
    f32x4* DL = (f32x4*)((float*)(p.ws + WS_DL) + (size_t)chain * 36 * 2048) + tid; const float* DV = (const float*)(p.ws + WS_DV) + (size_t)chain * 36 * 32 + (tid >> 4);
#pragma unroll 1
    for (int c0 = 0; c0 < 36; c0 += 12) {
        f32x4 loc[12]; float dv[12];
#pragma unroll
        for (int i = 0; i < 12; ++i) { loc[i] = DL[(size_t)(c0 + i) * 512]; dv[i] = DV[(c0 + i) * 32]; }
#pragma unroll
        for (int i = 0; i < 12; ++i) { u32x2 w_; w_.x = pk2(S[0], S[1]); w_.y = pk2(S[2], S[3]);
            *(u32x2*)((bf16_t*)((char*)p.out + 108 * MiB) + ((size_t)chain * 36 + c0 + i) * 2048 + tid * 4) = w_; S = S * dv[i] + loc[i]; }
    }
}
__device__ __forceinline__ void ph_mixers1(const Params& p, int l, float* lds, int bid, int nb, int wv) {
    const int tid = opq(TIDX(wv)), lane = tid & 63, wave = tid >> 6;
    float* wl = lds + wave * (WY_LDS / 4);
    const int gw = wv * nb + bid, NGW = nb * 8;
    {
    { LAS unsigned char* wl3 = (LAS unsigned char*)lds + wv * WY_LDS;
      for (int t = gw; t < 9216; t += NGW) { if (t < 4608) wyC_pass1(p, t, wl3, lane); else glaD_pass1(p, t - 4608, wl3, lane); } }
    }
    __syncthreads();
    LAS unsigned char* lds3 = (LAS unsigned char*)lds;
    for (int rp = 0; rp < 1 + ((PROBE_MASK >> 15) & 1); ++rp)
    for (int it = bid; it < 512; it += nb) { const int b = it >> 5, g = (it >> 4) & 1, qb = it & 15, hq = 2 * g + (wave >> 2);
        attn_mfma_unit<true>(p, lds3, b * 2048 + qb * 128 + (wave & 3) * 32, C_AQ + hq * 64, hq * 64, C_AK + g * 64, C_AV + g * 64, b * 2048, 2048, TL + b * 256, 256, wv); }
}
constexpr int WQ_MAIN = WI2 - WI0;
constexpr int Q_CTX = 256, Q_NA = Q_CTX + 128, Q_WC = Q_NA + 512, Q_RT = Q_WC + (WQ_MAIN + 63) / 64, Q_END = Q_RT + 1;
constexpr int WQ2_PULLS = (WI5 - WI2) / 16, WQ3_PULLS = WI0 / 16;
__device__ __forceinline__ void wconv_steal_q(const Params& p, int lw, int first, int npulls, unsigned* ctr, float* lds, LAS int* tab, int npull, int wv) {
    const int tid = opq(TIDX(wv)), lane = tid & 63, wave = tid >> 6;
    float* scr = lds + wave * 2112;
    for (int k = 0; npull < 0 || k < npull; ++k) {
        __syncthreads();
        if (tid == 0) tab[62] = (int)atomicAdd(ctr, 1u);
        __syncthreads();
        const int it = tab[62];
        if (it >= npulls) break;
        wconv_wave_item(p, lw, first + it * 16 + wave, scr, lane); wconv_wave_item(p, lw, first + it * 16 + 8 + wave, scr, lane);
    }
    __syncthreads();
}
__device__ __forceinline__ void wconv_steal(const Params& p, int l, float* lds, LAS int* tab, int npull, int wv) {
    wconv_steal_q(p, l, WI2, WQ2_PULLS, (unsigned*)(p.ws + WS_CTL) + CW_Q + l * 64 + 16, lds, tab, npull, wv); }
__device__ __forceinline__ void wconv_steal_in(const Params& p, int l, float* lds, LAS int* tab, int npull, int wv) {
    if (l + 1 < NL) wconv_steal_q(p, l + 1, 0, WQ3_PULLS, (unsigned*)(p.ws + WS_CTL) + CW_Q + l * 64 + 24, lds, tab, npull, wv); }
__device__ __forceinline__ void ph_mixers2(const Params& p, int l, float* lds, LAS int* tab, int bid, int nb, int wv) {
    const int tid = opq(TIDX(wv)), lane = tid & 63, wave = tid >> 6;
    LAS unsigned char* lds3 = (LAS unsigned char*)lds;
    unsigned* qctr = (unsigned*)(p.ws + WS_CTL) + CW_Q + l * 64;
    for (;;) {
        __syncthreads();
        if (tid == 0) tab[60] = (int)atomicAdd(qctr, 1u);
        __syncthreads();
        const int it = tab[60] - 1;
        if (it >= Q_RT) break;
        if (it < 0) router_relayout(p, l, tid);
        else if (it < 128) chainC_item(p, it, lds, wv);
        else if (it < 256) chainD_item(p, it - 128, wv);
        else if (it < Q_NA) { const int u = it - Q_CTX;
            if (l == NL - 1) { }
            else if (u < 64) { const int b = u >> 2, g = (u >> 1) & 1, qb = u & 1, hq = 2 * g + (wave >> 2);
                attn_mfma_unit<true>(p, lds3, TL + b * 256 + qb * 128 + (wave & 3) * 32, C_AQ + hq * 64, hq * 64, C_AK + g * 64, C_AV + g * 64, TL + b * 256, 256, 0, 0, wv); }
            else { const int b = (u - 64) >> 2, hb = u & 3;
                attn_mfma_unit<false>(p, lds3, TL + b * 256 + wave * 32, C_BQ + hb * 64, 256 + hb * 64, C_BK + hb * 64, C_BV + hb * 64, TL + b * 256, 256, 0, 0, wv); } }
        else if (it < Q_WC) { const int u = it - Q_NA, b = u >> 5, hb = (u >> 3) & 3, rg = u & 7; attn_na_unit(p, lds3, l, b, hb, rg, wv); }
        else if (it < Q_RT) { float* scr = lds + wave * 2112;
            for (int k = 0; k < 8; ++k) { const int wi = (it - Q_WC) * 64 + k * 8 + wave;
                if (wi < WQ_MAIN) wconv_wave_item(p, l, WI0 + wi, scr, lane); } }
        else { }
    }
    if (l == NL - 1) wconv_steal(p, l, lds, tab, -1, wv);
}
__device__ __forceinline__ void ph_mixers3(const Params& p, int l, float* lds, int bid, int nb, int wv) {
    const int tid = opq(TIDX(wv)), lane = tid & 63, wave = tid >> 6;
    float* wl = lds + wave * 3200;
    const int gw = wv * nb + bid, NGW = nb * 8;
    { LAS unsigned char* wl3 = (LAS unsigned char*)lds + wv * WY_LDS;
      for (int t = gw; t < 9216; t += NGW) { const int tk = t < 4608 ? t : t - 4608;
          if (l == NL - 1 && tk % 36 < 4) continue;
          if (t < 4608) wyC_pass3(p, tk, lane); else glaD_pass3(p, tk, wl3, lane); } }
}
__device__ __forceinline__ void ph_gated(const Params& p, int l, int bid, int nb, int wv) {
    const int tid = opq(TIDX(wv)), lane = tid & 63, wave = tid >> 6;
    const bf16_t* P = (const bf16_t*)(p.ws + WS_P); bf16_t* O = (bf16_t*)(p.ws + WS_O);
    const bf16_t* OC = (const bf16_t*)(p.ws + WS_X + X_OC); const bf16_t* OD = (const bf16_t*)(p.ws + WS_H);
    const f32x4 cg = *(const f32x4*)(p.in[I_COG] + l * 64 + (lane & 15) * 4), dg = *(const f32x4*)(p.in[I_DOG] + l * 64 + (lane & 15) * 4);
    for (int r0 = (bid * 8 + wave) * 2; r0 < (l == NL - 1 ? TL : TT); r0 += nb * 16) {
        u32x2 a[2][2], b[2][2], g[2][2];
#pragma unroll
        for (int q = 0; q < 2; ++q)
#pragma unroll
            for (int mix = 0; mix < 2; ++mix) { const bf16_t* od = mix ? OD : OC; const size_t r = (size_t)(r0 + q);
                a[q][mix] = *(const u32x2*)(od + r * 256 + lane * 4); b[q][mix] = *(const u32x2*)(od + (size_t)TT * 256 + r * 256 + lane * 4);
                g[q][mix] = *(const u32x2*)(P + r * NPAD + (mix ? C_DG : C_CG) + lane * 4); }
#pragma unroll
        for (int q = 0; q < 2; ++q)
#pragma unroll
            for (int mix = 0; mix < 2; ++mix) {
                float o[4] = {bflo(a[q][mix].x) + bflo(b[q][mix].x), bfhi(a[q][mix].x) + bfhi(b[q][mix].x), bflo(a[q][mix].y) + bflo(b[q][mix].y), bfhi(a[q][mix].y) + bfhi(b[q][mix].y)};
                const float gt[4] = {bflo(g[q][mix].x), bfhi(g[q][mix].x), bflo(g[q][mix].y), bfhi(g[q][mix].y)};
                float ss = (o[0] * o[0] + o[1] * o[1]) + (o[2] * o[2] + o[3] * o[3]);
                ss = row16_sum(ss);
                const float rn = rsqrtf(ss * (1.f / 64.f) + EPS); const f32x4 gn = mix ? dg : cg;
#pragma unroll
                for (int e = 0; e < 4; ++e) o[e] = o[e] * rn * gn[e] * silu_f(gt[e]);
                u32x2 w; w.x = pk2(o[0], o[1]); w.y = pk2(o[2], o[3]);
                *(u32x2*)(O + (size_t)(r0 + q) * D + 512 + mix * 256 + lane * 4) = w; }
    }
}
constexpr int LN1_R = 2;
__device__ __forceinline__ void ph_ln1_route(const Params& p, int l, int M, LAS unsigned char* lds3, LAS int* tab, int bid, int nb, int wv, int dry = 0) {
    const int tid = opq(TIDX(wv)), lane = tid & 63, wave = tid >> 6;
    const bf16_t* Y = (const bf16_t*)(p.ws + WS_X + X_Y);
    bf16_t* H = dry ? (bf16_t*)(p.ws + WS_CL) : (bf16_t*)(p.ws + WS_H);
    const float* mod = (const float*)(p.ws + WS_MOD) + (size_t)l * 17 * 6144;
    const float* lg_ = p.in[I_LN1G] + l * D; const float* lb_ = p.in[I_LN1B] + l * D;
    const float* wrg0 = (const float*)(p.ws + WS_W + W_RG);
    unsigned* cnt = (unsigned*)(p.ws + WS_CTL) + CW_CNT + l * 32 + (dry ? 1024 : 0);
    int* lists = dry ? (int*)(p.ws + WS_DL) : (int*)(p.ws + WS_LIST); float* wt = dry ? (float*)(p.ws + WS_DL) + 8 * 1024 * 1024 : (float*)(p.ws + WS_WT);
    LAS int* lcnt = tab + 64; LAS int* gbase = tab + 96; LAS int* rec = tab + 128;
    __syncthreads();
    if (tid < 32) lcnt[tid] = 0;
    {
        const f32x4* RE4 = (const f32x4*)(p.ws + WS_W + W_RE);
        {   f32x4 tmp_[16];
#pragma unroll
            for (int k = 0; k < 16; ++k) tmp_[k] = RE4[tid + k * NTHR];
            __builtin_amdgcn_sched_barrier(0);
#pragma unroll
            for (int k = 0; k < 16; ++k) { const int i4 = tid + k * NTHR, blk = i4 >> 7, off = i4 & 127, ln = off >> 1, kh = off & 1;
                *(LAS f32x4*)(lds3 + (unsigned)(blk * 512 + kh * 256 + ln * 4) * 4u) = tmp_[k]; } }
        {   float ga_[6], gb_[6];
#pragma unroll
            for (int k = 0; k < 6; ++k) { const int i = tid + k * NTHR, e = i & 3, ln = (i >> 2) & 63, j = (i >> 8) & 3, g1 = i >> 10; const float* s_ = wrg0 + ((j * 4 + e) * 64 + ln) * 4;
                ga_[k] = s_[g1 + 1]; gb_[k] = s_[0]; }
            __builtin_amdgcn_sched_barrier(0);
#pragma unroll
            for (int k = 0; k < 6; ++k) *(LAS float*)(lds3 + 131072u + (unsigned)(tid + k * NTHR) * 4u) = ga_[k] - gb_[k]; } }
    __syncthreads();
    int kit = 0;
    const float brg_l = p.in[I_BRG][l * 4 + (lane & 3)], bre_l = p.in[I_BRE][l * 32 + (lane & 31)];
    f32x4 g4r[4], b4r[4];
#pragma unroll
    for (int j = 0; j < 4; ++j) { g4r[j] = *(const f32x4*)(lg_ + j * 256 + lane * 4); b4r[j] = *(const f32x4*)(lb_ + j * 256 + lane * 4); }
    h16x4 xq[LN1_R][4]; u32x2 yq[LN1_R][4];
#define LN1_FETCH(r_) do { _Pragma("unroll") for (int q_ = 0; q_ < LN1_R; ++q_) _Pragma("unroll") for (int j_ = 0; j_ < 4; ++j_) { \
        xq[q_][j_] = *(const h16x4*)((const _Float16*)p.out + (size_t)((r_) + q_) * D + j_ * 256 + lane * 4); yq[q_][j_] = *(const u32x2*)(Y + (size_t)((r_) + q_) * D + j_ * 256 + lane * 4); } } while (0)
    { const int rf = (bid * 8 + wave) * LN1_R; if (rf < M) LN1_FETCH(rf); }
    for (int r0 = (bid * 8 + wave) * LN1_R; r0 < M; r0 += nb * 8 * LN1_R, ++kit) {
        const float* m = mod + (size_t)brow(r0) * 6144;
        f32x4 s2r[4], sh2r[4];
#pragma unroll
        for (int j = 0; j < 4; ++j) { s2r[j] = *(const f32x4*)(m + 4096 + j * 256 + lane * 4); sh2r[j] = *(const f32x4*)(m + 3072 + j * 256 + lane * 4); }
        float v[LN1_R][16]; float s[LN1_R];
#pragma unroll
        for (int q = 0; q < LN1_R; ++q) { s[q] = 0.f;
#pragma unroll
            for (int j = 0; j < 4; ++j) { const int c = j * 256 + lane * 4; const f32x4 xv = __builtin_convertvector(xq[q][j], f32x4);
                const f32x4 gv = *(const f32x4*)(m + 2048 + c);
                const u32x2 yw = yq[q][j]; const float yv[4] = {bflo(yw.x), bfhi(yw.x), bflo(yw.y), bfhi(yw.y)};
#pragma unroll
                for (int e = 0; e < 4; ++e) { v[q][j * 4 + e] = DN_ALPHA * xv[e] + gv[e] * yv[e]; s[q] += v[q][j * 4 + e]; } } }
        float qq[LN1_R];
#pragma unroll
        for (int q = 0; q < LN1_R; ++q) { const float mean = wave_sum(s[q]) * (1.f / D); qq[q] = 0.f;
#pragma unroll
            for (int i = 0; i < 16; ++i) { v[q][i] -= mean; qq[q] += v[q][i] * v[q][i]; } }
#pragma unroll
        for (int q = 0; q < LN1_R; ++q) { const float rstd = rsqrtf(wave_sum(qq[q]) * (1.f / D) + EPS); _Float16* x1 = (_Float16*)(p.ws + (dry ? WS_CM : WS_O)) + (size_t)(r0 + q) * D;
#pragma unroll
            for (int j = 0; j < 4; ++j) { const int c = j * 256 + lane * 4; const f32x4 g4 = g4r[j], b4 = b4r[j], s2 = s2r[j], sh2 = sh2r[j];
                f32x4 o;
#pragma unroll
                for (int e = 0; e < 4; ++e) { o[e] = v[q][j * 4 + e] * rstd * g4[e] + b4[e]; v[q][j * 4 + e] = o[e] * (1.f + s2[e]) + sh2[e]; }
                sth4(x1 + c, o);
                u32x2 hw; hw.x = pk2(v[q][j * 4], v[q][j * 4 + 1]); hw.y = pk2(v[q][j * 4 + 2], v[q][j * 4 + 3]); *(u32x2*)(H + (size_t)(r0 + q) * D + c) = hw; } }
        __builtin_amdgcn_sched_barrier(0);
        { const int rn = r0 + nb * 8 * LN1_R; if (rn < M) LN1_FETCH(rn); }
        __builtin_amdgcn_sched_barrier(0);
        float lg[LN1_R][4];
#pragma unroll
        for (int q = 0; q < LN1_R; ++q)
#pragma unroll
            for (int g = 0; g < 4; ++g) lg[q][g] = 0.f;
        { f32x4 wgq[4][3];
#pragma unroll
          for (int j = 0; j < 4; ++j)
#pragma unroll
              for (int g1 = 0; g1 < 3; ++g1) wgq[j][g1] = *(const LAS f32x4*)(lds3 + 131072u + (unsigned)(((g1 * 4 + j) * 64 + lane) * 16));
          __builtin_amdgcn_sched_barrier(0);
#pragma unroll
          for (int j = 0; j < 4; ++j)
#pragma unroll
              for (int g1 = 0; g1 < 3; ++g1)
#pragma unroll
                  for (int q = 0; q < LN1_R; ++q)
#pragma unroll
                      for (int e = 0; e < 4; ++e) lg[q][g1 + 1] += v[q][j * 4 + e] * wgq[j][g1][e];
          __builtin_amdgcn_sched_barrier(0); }
        int grp[LN1_R]; float pgrp[LN1_R];
#pragma unroll
        for (int q = 0; q < LN1_R; ++q) {
#pragma unroll
            for (int g = 1; g < 4; ++g) lg[q][g] = wave_sum(lg[q][g]) + (__int_as_float(__builtin_amdgcn_readlane(__float_as_int(brg_l), g)) - __int_as_float(__builtin_amdgcn_readlane(__float_as_int(brg_l), 0)));
            grp[q] = 0; float gm = lg[q][0];
#pragma unroll
            for (int g = 1; g < 4; ++g) if (lg[q][g] > gm) { gm = lg[q][g]; grp[q] = g; }
            float gs = 0.f;
#pragma unroll
            for (int g = 0; g < 4; ++g) gs += expf(lg[q][g] - gm);
            pgrp[q] = 1.f / gs; }
        float ev[LN1_R][8];
#pragma unroll
        for (int q = 0; q < LN1_R; ++q) { const LAS float* wre_g = (const LAS float*)lds3 + grp[q] * 8192 + lane * 4;
#pragma unroll
            for (int k = 0; k < 8; ++k) ev[q][k] = 0.f;
#pragma unroll
            for (int j = 0; j < 4; ++j) { f32x4 w0[4], w1[4];
#pragma unroll
                for (int e = 0; e < 4; ++e) { w0[e] = *(const LAS f32x4*)(wre_g + (j * 4 + e) * 512); w1[e] = *(const LAS f32x4*)(wre_g + (j * 4 + e) * 512 + 256); }
                __builtin_amdgcn_sched_barrier(0);
#pragma unroll
                for (int e = 0; e < 4; ++e) { const float hv = v[q][j * 4 + e];
#pragma unroll
                    for (int k = 0; k < 4; ++k) { ev[q][k] += hv * w0[e][k]; ev[q][4 + k] += hv * w1[e][k]; } }
                __builtin_amdgcn_sched_barrier(0); } }
        int ea[LN1_R], eb[LN1_R]; float w0s[LN1_R], w1s[LN1_R];
#pragma unroll
        for (int q = 0; q < LN1_R; ++q) {
#pragma unroll
            for (int k = 0; k < 8; ++k) ev[q][k] = wave_sum(ev[q][k]) + __int_as_float(__builtin_amdgcn_readlane(__float_as_int(bre_l), __builtin_amdgcn_readfirstlane(grp[q]) * 8 + k));
            int i0 = 0; float m0 = ev[q][0];
#pragma unroll
            for (int k = 1; k < 8; ++k) if (ev[q][k] > m0) { m0 = ev[q][k]; i0 = k; }
            int i1 = -1; float m1 = -INFINITY;
#pragma unroll
            for (int k = 0; k < 8; ++k) if (k != i0 && ev[q][k] > m1) { m1 = ev[q][k]; i1 = k; }
            if (i1 < 0) i1 = (i0 + 1) & 7;
            const float e1 = expf(m1 - m0);
            w0s[q] = pgrp[q] / (1.f + e1); w1s[q] = pgrp[q] * e1 / (1.f + e1); ea[q] = grp[q] * 8 + i0; eb[q] = grp[q] * 8 + i1; }
        if (lane == 0) {
#pragma unroll
            for (int q = 0; q < LN1_R; ++q) { const int r = r0 + q, li = (kit * 8 + wave) * LN1_R + q;
                const int sa = __hip_atomic_fetch_add(lcnt + ea[q], 1, __ATOMIC_RELAXED, __HIP_MEMORY_SCOPE_WORKGROUP), sb = __hip_atomic_fetch_add(lcnt + eb[q], 1, __ATOMIC_RELAXED, __HIP_MEMORY_SCOPE_WORKGROUP);
                rec[li * 4] = ea[q]; rec[li * 4 + 1] = sa; rec[li * 4 + 2] = eb[q]; rec[li * 4 + 3] = sb; wt[r * 2] = w0s[q]; wt[r * 2 + 1] = w1s[q]; }
        }
    }
    __syncthreads();
    if (tid < 32) gbase[tid] = (int)atomicAdd(cnt + tid, (unsigned)lcnt[tid]);
    __syncthreads();
    {
        const int nrows_blk = ((M + nb * 8 * LN1_R - 1) / (nb * 8 * LN1_R)) * 8 * LN1_R;
        for (int i = tid; i < nrows_blk * 2; i += NTHR) { const int li = i >> 1, k = i & 1;
            const int q = li % LN1_R, w8 = (li / LN1_R) & 7, kk = li / (8 * LN1_R);
            const int r = (bid * 8 + w8) * LN1_R + kk * (nb * 8 * LN1_R) + q;
            if (r < M) { const int e = rec[li * 4 + 2 * k], s = rec[li * 4 + 2 * k + 1]; lists[(size_t)e * (TT * 2) + gbase[e] + s] = r * 2 + k; } }
    }
}
__device__ __forceinline__ void moe_table(const Params& p, int l, LAS int* ts, int wv) {
    const unsigned* cnt = (const unsigned*)(p.ws + WS_CTL) + CW_CNT + l * 32;
    if (wv == 0) {
        const int ln = lane_now(); const int tl = (ln < 32) ? (((int)cnt[ln & 31] + 255) >> 8) : 0; int a = 0, mine = 0;
#pragma unroll
        for (int e = 0; e < NEXP; ++e) { const int te = __builtin_amdgcn_readlane(tl, e); mine = (ln == e) ? a : mine; a += te; }
        if (ln < 32) ts[ln] = mine;
        if (ln == 32) ts[32] = a; }
    __syncthreads();
}
__device__ __forceinline__ void ph_ln2(const Params& p, int l, int M, int bid, int nb, int wv, int dry = 0) {
    const int tid = opq(TIDX(wv)), lane = tid & 63, wave = tid >> 6;
    const bf16_t* Ye = (const bf16_t*)(p.ws + WS_P + P_YE);
    const float* wt = (const float*)(p.ws + WS_WT);
    const float* mod = (const float*)(p.ws + WS_MOD) + (size_t)l * 17 * 6144;
    const float* lg_ = p.in[I_LN2G] + l * D; const float* lb_ = p.in[I_LN2B] + l * D;
    const float* wt_ = wt;
    f32x4 g4[4], b4[4];
#pragma unroll
    for (int j = 0; j < 4; ++j) { g4[j] = *(const f32x4*)(lg_ + j * 256 + lane * 4); b4[j] = *(const f32x4*)(lb_ + j * 256 + lane * 4); }
    for (int r0 = (bid * 8 + wave) * 2; r0 < M; r0 += nb * 16) {
        const float* m = mod + (size_t)brow(r0) * 6144;
        const float* mn = mod + 17 * 6144 + (size_t)brow(r0) * 6144;
        f32x4 s1n[4], shn[4];
        if (l + 1 < NL) {
#pragma unroll
            for (int j = 0; j < 4; ++j) { s1n[j] = *(const f32x4*)(mn + 1024 + j * 256 + lane * 4); shn[j] = *(const f32x4*)(mn + j * 256 + lane * 4); } }
        else {
#pragma unroll
            for (int j = 0; j < 4; ++j) { s1n[j] = (f32x4){0.f, 0.f, 0.f, 0.f}; shn[j] = s1n[j]; } }
        float v[2][16], s[2];
#pragma unroll
        for (int q = 0; q < 2; ++q) { const int r = r0 + q; const _Float16* x1 = (const _Float16*)(p.ws + WS_O) + (size_t)r * D;
            const float w0 = wt_[r * 2], w1 = wt_[r * 2 + 1];
            const bf16_t* y0p = Ye + (size_t)(r * 2) * D; const bf16_t* y1p = Ye + (size_t)(r * 2 + 1) * D;
            s[q] = 0.f;
#pragma unroll
            for (int j = 0; j < 4; ++j) { const int c = j * 256 + lane * 4; const f32x4 xv = ldh4(x1 + c), gv = *(const f32x4*)(m + 5120 + c);
                const u32x2 a = *(const u32x2*)(y0p + c), b = *(const u32x2*)(y1p + c);
                const float y0[4] = {bflo(a.x), bfhi(a.x), bflo(a.y), bfhi(a.y)}, y1[4] = {bflo(b.x), bfhi(b.x), bflo(b.y), bfhi(b.y)};
#pragma unroll
                for (int e = 0; e < 4; ++e) { v[q][j * 4 + e] = DN_ALPHA * xv[e] + gv[e] * (w0 * y0[e] + w1 * y1[e]); s[q] += v[q][j * 4 + e]; } } }
        float qq[2];
#pragma unroll
        for (int q = 0; q < 2; ++q) { const float mean = wave_sum(s[q]) * (1.f / D); qq[q] = 0.f;
#pragma unroll
            for (int i = 0; i < 16; ++i) { v[q][i] -= mean; qq[q] += v[q][i] * v[q][i]; } }
        bf16_t* Hn = dry ? (bf16_t*)(p.ws + WS_CL) : (bf16_t*)(p.ws + WS_H);
#pragma unroll
        for (int q = 0; q < 2; ++q) { const int r = r0 + q; const float rstd = rsqrtf(wave_sum(qq[q]) * (1.f / D) + EPS);
#pragma unroll
            for (int j = 0; j < 4; ++j) { const int c = j * 256 + lane * 4; f32x4 o;
#pragma unroll
                for (int e = 0; e < 4; ++e) o[e] = v[q][j * 4 + e] * rstd * g4[j][e] + b4[j][e];
                if (l + 1 >= NL) *(f32x4*)((dry ? (float*)(p.ws + WS_CM) + (size_t)(r & 8191) * D : p.out + (size_t)r * D) + c) = o;
                else { sth4((dry ? (_Float16*)(p.ws + WS_CM) : (_Float16*)p.out) + (size_t)r * D + c, o);
                    const f32x4 s1 = s1n[j], sh = shn[j];
                    u32x2 hw; hw.x = pk2(o[0] * (1.f + s1[0]) + sh[0], o[1] * (1.f + s1[1]) + sh[1]); hw.y = pk2(o[2] * (1.f + s1[2]) + sh[2], o[3] * (1.f + s1[3]) + sh[3]);
                    *(u32x2*)(Hn + (size_t)r * D + c) = hw; } } }
    }
}

__global__ void __launch_bounds__(NTHR, 2) fwd_kernel(Params p) {
    extern __shared__ __attribute__((aligned(16))) unsigned char smem[];
    float* lds = (float*)smem;
    LAS unsigned char* lds3 = (LAS unsigned char*)smem;
    volatile LAS unsigned* misc = (volatile LAS unsigned*)(lds3 + LDS_MISC);
    LAS int* ts = (LAS int*)(lds3 + LDS_TAB);
    const int tid = threadIdx.x, bid = blockIdx.x, nb = gridDim.x;
    const int wv = __builtin_amdgcn_readfirstlane(tid >> 6);
    if (tid < 4) misc[tid] = 0u;
    __syncthreads();
#if defined(__HIP_DEVICE_COMPILE__)
#define WSPTR() (kp_get()->ws)
#else
#define WSPTR() (p.ws)
#endif
#if MK_SINGLE
    { XcdBarrier b0 = xcd_barrier_post((unsigned*)(WSPTR() + WS_CTL) + CW_BAR, misc); (void)b0; }
#endif
    const int lo = p.ph_lo, hi = p.ph_hi; (void)lo; (void)hi;
#if MK_SINGLE
#define IN(k) true
#define SEAM(k) do { if ((k) + 1 < NPH) { XcdBarrier b_; b_.bar = (unsigned*)(WSPTR() + WS_CTL) + CW_BAR; b_.x = xb_xcc_id(); b_.st = misc; xcd_barrier(b_, wv); } } while (0)
#else
#define IN(k) (lo <= (k) && (k) < hi)
#define SEAM(k) do { } while (0)
#endif
    if (IN(0)) { LOADP(); ph_init(q, lds, bid, nb, wv); }
    SEAM(0);
#define H_ ((bf16_t*)(q.ws + WS_H))
#define P_ ((bf16_t*)(q.ws + WS_P))
#define O_ ((bf16_t*)(q.ws + WS_O))
#define Mg_ ((bf16_t*)(q.ws + WS_X + X_MG))
#define Yb_ ((bf16_t*)(q.ws + WS_X + X_Y))
#define As_ ((bf16_t*)(q.ws + WS_P + P_AS))
#define Hid_ ((bf16_t*)(q.ws + WS_P + P_HID))
#define Yexp_ ((bf16_t*)(q.ws + WS_P + P_YE))
    for (int l = 0; l < NL; ++l) {
        const int base = 1 + l * NPL;
        const int M2 = (l == NL - 1) ? TL : TT;
        if (l == 0) { { LOADP(); ph_wconv_mod(q, l, lds, bid, nb, wv); }
        SEAM(base + 0); }
        for (int rep_ = 0; rep_ < 1 + ((PROBE_MASK >> 1) & 1); ++rep_) { LOADP();
            pg8::Gemm g{H_, (const bf16_t*)(q.ws + WS_W + W_IN), TT, NPAD, D, D, D, 0}; pg8::StaticOrder S; S.init(TT, NPAD, nb, bid);
            pg8::EpiStore E{P_, NPAD};
            pg8::gemm_phase<pg8::EpiStore, pg8::StaticOrder>(lds3, g, S, E, wv);
            { const int nwg_ = (TT / 256) * (NPAD / 256); if ((nwg_ - bid + nb - 1) / nb < (nwg_ + nb - 1) / nb) wconv_steal(q, l, lds, ts, 3, wv); } }
        SEAM(base + 1);
        for (int rep_ = 0; rep_ < 1 + ((PROBE_MASK >> 2) & 1); ++rep_) { LOADP(); if ((PROBE_MASK >> 17) & 1) ph_prep(q, l, bid, nb, wv, 1); ph_prep(q, l, bid, nb, wv); }
        SEAM(base + 2);
        for (int rep_ = 0; rep_ < 1 + ((PROBE_MASK >> 3) & 1); ++rep_) { LOADP(); ph_mixers1(q, l, lds, bid, nb, wv); }
        SEAM(base + 3);
        for (int rep_ = 0; rep_ < 1 + ((PROBE_MASK >> 4) & 1); ++rep_) { LOADP(); ph_mixers2(q, l, lds, ts, bid, nb, wv); }
        SEAM(base + 4);
        for (int rep_ = 0; rep_ < 1 + ((PROBE_MASK >> 5) & 1); ++rep_) { LOADP(); ph_mixers3(q, l, lds, bid, nb, wv); }
        SEAM(base + 5);
        for (int rep_ = 0; rep_ < 1 + ((PROBE_MASK >> 6) & 1); ++rep_) { LOADP(); ph_gated(q, l, bid, nb, wv); }
        SEAM(base + 6);
        for (int rep_ = 0; rep_ < 1 + ((PROBE_MASK >> 7) & 1); ++rep_) { LOADP();
            pg8::GatedMerge g{O_, (const bf16_t*)(q.ws + WS_W + W_BR), P_ + C_GATES, NPAD, Mg_, M2};
            pg8::gemm_gated_phase(lds3, g, nb, bid, wv);
            { const int nwg_ = (M2 / 256) * 8; if ((nwg_ - bid + nb - 1) / nb < (nwg_ + nb - 1) / nb) wconv_steal(q, l, lds, ts, 6, wv); } }
        SEAM(base + 7);
        for (int rep_ = 0; rep_ < 1 + ((PROBE_MASK >> 8) & 1); ++rep_) { LOADP();
            pg8::Gemm g{Mg_, (const bf16_t*)(q.ws + WS_W + W_OUT), M2, D, D, D, D, 0}; pg8::StaticOrder S; S.init(M2, D, nb, bid);
            pg8::EpiStore E{Yb_, D};
            pg8::gemm_phase<pg8::EpiStore, pg8::StaticOrder>(lds3, g, S, E, wv);
            { const int nwg_ = (M2 / 256) * 4; if ((nwg_ - bid + nb - 1) / nb < (nwg_ + nb - 1) / nb) wconv_steal(q, l, lds, ts, 3, wv); } }
        SEAM(base + 8);
        for (int rep_ = 0; rep_ < 1 + ((PROBE_MASK >> 9) & 1); ++rep_) { LOADP(); wconv_steal(q, l, lds, ts, -1, wv); if ((PROBE_MASK >> 18) & 1) ph_ln1_route(q, l, M2, lds3, ts, bid, nb, wv, 1); ph_ln1_route(q, l, M2, lds3, ts, bid, nb, wv); }
        SEAM(base + 9);
        for (int rep_ = 0; rep_ < 1 + ((PROBE_MASK >> 11) & 1); ++rep_) { LOADP();
            moe_table(q, l, ts, wv);
            pg8::Gemm g{H_, (const bf16_t*)(q.ws + WS_W + W_GU), MOE_ROWS, 1024, D, D, D, (size_t)1024 * 1024};
            pg8::ExpertOrder S{4, nb, bid, ts, (const unsigned*)(q.ws + WS_CTL) + CW_CNT + l * 32, (const int*)(q.ws + WS_LIST)};
            pg8::EpiSwiglu E{Hid_, EH};
            pg8::gemm_phase_gather<pg8::EpiSwiglu, pg8::ExpertOrder>(lds3, g, S, E, wv);
            { const int nwg_ = ts[32] * 4; if ((nwg_ - bid + nb - 1) / nb < (nwg_ + nb - 1) / nb) wconv_steal_in(q, l, lds, ts, 3, wv); } }
        SEAM(base + 10);
        for (int rep_ = 0; rep_ < 1 + ((PROBE_MASK >> 12) & 1); ++rep_) { LOADP();
            moe_table(q, l, ts, wv);
            pg8::Gemm g{Hid_, (const bf16_t*)(q.ws + WS_W + W_DN), MOE_ROWS, D, EH, EH, EH, (size_t)1024 * 512};
            pg8::ExpertOrder S{4, nb, bid, ts, (const unsigned*)(q.ws + WS_CTL) + CW_CNT + l * 32, (const int*)(q.ws + WS_LIST)};
            pg8::EpiScatter<pg8::ExpertOrder> E{Yexp_, D, &S};
            pg8::gemm_phase<pg8::EpiScatter<pg8::ExpertOrder>, pg8::ExpertOrder>(lds3, g, S, E, wv);
            { const int nwg_ = ts[32] * 4; if ((nwg_ - bid + nb - 1) / nb < (nwg_ + nb - 1) / nb) wconv_steal_in(q, l, lds, ts, 2, wv); } }
        SEAM(base + 11);
        for (int rep_ = 0; rep_ < 1 + ((PROBE_MASK >> 13) & 1); ++rep_) { LOADP(); wconv_steal_in(q, l, lds, ts, -1, wv); if ((PROBE_MASK >> 19) & 1) ph_ln2(q, l, M2, bid, nb, wv, 1); ph_ln2(q, l, M2, bid, nb, wv); }
        SEAM(base + 12);
    }
#undef IN
#undef SEAM
}

extern "C" void kernel_launch(void* const* d_in, const int* in_sizes, int n_in, void* d_out, int out_size, void* d_ws, size_t ws_size, hipStream_t stream) {
    static int grid = 0;
    if (grid == 0) {
        if (n_in != 30 || ws_size < WS_END) { fprintf(stderr, "kernel_launch: unexpected n_in %d or ws_size %zu\n", n_in, ws_size); grid = -1; return; }
        int dev = 0, cus = 0;
        if (hipGetDevice(&dev) != hipSuccess || hipDeviceGetAttribute(&cus, hipDeviceAttributeMultiprocessorCount, dev) != hipSuccess) { grid = -1; return; }
        if (hipFuncSetAttribute((const void*)fwd_kernel, hipFuncAttributeMaxDynamicSharedMemorySize, LDS_BYTES) != hipSuccess) { grid = -1; return; }
        int per_cu = 0;
        (void)hipOccupancyMaxActiveBlocksPerMultiprocessor(&per_cu, (const void*)fwd_kernel, NTHR, LDS_BYTES);
        (void)hipGetLastError();
        grid = cus;
    }
    if (grid < 0) return;
    (void)hipMemsetAsync((char*)d_ws + WS_CTL, 0, CTL_BYTES, stream);
    Params p{};
    for (int i = 0; i < 30; ++i) p.in[i] = (const float*)d_in[i];
    p.out = (float*)d_out; p.ws = (unsigned char*)d_ws;
#if MK_SINGLE
    p.ph_lo = 0; p.ph_hi = NPH;
    hipLaunchKernelGGL(fwd_kernel, dim3(grid), dim3(NTHR), LDS_BYTES, stream, p);
#else
    for (int ph = 0; ph < NPH; ++ph) { p.ph_lo = ph; p.ph_hi = ph + 1; hipLaunchKernelGGL(fwd_kernel, dim3(grid), dim3(NTHR), LDS_BYTES, stream, p); }
#endif
}
```

```cpp
#include <hip/hip_runtime.h>
#include <stdint.h>
#include <stdio.h>

#ifndef MK_SINGLE
#define MK_SINGLE 1
#endif
#ifndef PROBE_MASK
#define PROBE_MASK 0
#endif

#define LAS __attribute__((address_space(3)))
__device__ __forceinline__ int lane_now() { int l; asm volatile("v_mbcnt_lo_u32_b32 %0, -1, 0\n\tv_mbcnt_hi_u32_b32 %0, -1, %0" : "=v"(l)); return l; }
#define TIDX(wv) ((int)((((unsigned)(wv)) << 6) | (unsigned)lane_now()))
typedef float f32x4 __attribute__((ext_vector_type(4)));
typedef float f32x2 __attribute__((ext_vector_type(2)));
typedef unsigned u32x4 __attribute__((ext_vector_type(4)));
typedef unsigned u32x2 __attribute__((ext_vector_type(2)));
typedef short bf16x8 __attribute__((ext_vector_type(8)));
typedef unsigned short bf16_t;

constexpr int D = 1024, NB = 16, S = 2048, NL = 4, NCTX = 256, HD = 64;
constexpr int TL = NB * S, TC = NB * NCTX, TT = TL + TC;
constexpr int INW = 7216, NPAD = 7424;
constexpr int C_AQ = 0, C_AK = 256, C_AV = 384, C_BQ = 512, C_BK = 768, C_BV = 1024, C_CQKV = 1280, C_CBETA = 2048, C_CA = 2056,
              C_CG = 2064, C_DQ = 2320, C_DK = 2448, C_DV = 2576, C_DLR = 2832, C_DG = 2864, C_GATES = 3120;
constexpr int NEXP = 32, EH = 512;
constexpr float EPS = 1e-6f;
constexpr float DN_ALPHA = 1.6817928305074290f;
constexpr int NTHR = 512;
constexpr int NPL = 13;
constexpr int NPH = 1 + NL * NPL;
constexpr int MOE_ROWS = 82176;

constexpr size_t MiB = 1u << 20;
constexpr size_t WS_CTL = 0, CTL_BYTES = 1 * MiB;
constexpr size_t WS_MOD = 1 * MiB;
constexpr size_t WS_GB = 19 * MiB;
constexpr size_t WS_WT = 22 * MiB;
constexpr size_t WS_LIST = 23 * MiB;
constexpr size_t WS_W = 33 * MiB;
constexpr size_t   W_IN = 0;
constexpr size_t   W_BR = W_IN + (size_t)NPAD * 1024 * 2;
constexpr size_t   W_OUT = W_BR + (size_t)4 * 1024 * 256 * 2;
constexpr size_t   W_GU = W_OUT + (size_t)1024 * 1024 * 2;
constexpr size_t   W_DN = W_GU + (size_t)32 * 1024 * 1024 * 2;
constexpr size_t   W_RE = W_DN + (size_t)32 * 1024 * 512 * 2;
constexpr size_t   W_RG = W_RE + (size_t)4 * 1024 * 8 * 4;
constexpr size_t   W_END = W_RG + (size_t)1024 * 4 * 4;
static_assert(W_END <= 128 * MiB, "weights region");
constexpr size_t WS_H = 161 * MiB;
constexpr size_t WS_P = 233 * MiB;
constexpr size_t   P_AS = 0;
constexpr size_t   P_HID = P_AS + (size_t)MOE_ROWS * 1024 * 2;
constexpr size_t   P_YE = P_HID + (size_t)MOE_ROWS * 512 * 2;
static_assert(P_YE + (size_t)MOE_ROWS * 1024 * 2 <= (size_t)TT * NPAD * 2, "MoE overlay");
constexpr size_t WS_O = 755 * MiB;
constexpr size_t WS_X = 827 * MiB;
constexpr size_t   X_CQ = 0;
constexpr size_t   X_LA = X_CQ + (size_t)TT * 768 * 2;
constexpr size_t   X_OC = X_LA + (size_t)TT * 256 * 4;
constexpr size_t   X_MG = 0;
constexpr size_t   X_Y = (size_t)TT * 1024 * 2;
constexpr size_t WS_CM = 971 * MiB;
constexpr size_t WS_CL = 1043 * MiB;
constexpr size_t WS_DL = 1115 * MiB;
constexpr size_t WS_DV = 21 * MiB + 256 * 1024;
constexpr size_t WS_END = 1151 * MiB;
constexpr int CW_BAR = 4096;
constexpr int CW_CNT = 16384;
constexpr int CW_Q = 20480;
constexpr int LDS_MISC = 143360;
constexpr int LDS_TAB = 143360 + 64;
constexpr int LDS_BYTES = 147456;

#define XB_TMO      128
#define XB_XCNT(j)  (256  + 64 * (j))
#define XB_XSUB(j)  (1280 + 64 * (j))
#define XB_XGEN(j)  (2304 + 64 * (j))
#define XB_TOP      3328
#define XB_TOPGEN   3392
#define XCD_BAR_WORDS 3456
#define XB_SPIN_CAP (1u << 24)

__device__ __forceinline__ unsigned xb_ld(unsigned* p)              { return __hip_atomic_load(p, __ATOMIC_RELAXED, __HIP_MEMORY_SCOPE_AGENT); }
__device__ __forceinline__ unsigned xb_add(unsigned* p, unsigned v) { return __hip_atomic_fetch_add(p, v, __ATOMIC_RELAXED, __HIP_MEMORY_SCOPE_AGENT); }
__device__ __forceinline__ unsigned xb_xcc_id() { return (unsigned)__builtin_amdgcn_s_getreg((3 << 11) | 20) & 0xFu; }
#define XB_SPIN(cond, bar) do { unsigned _sp = 0; while (cond) { __builtin_amdgcn_s_sleep(1); \
    if ((++_sp & 255u) == 0u) { if (xb_ld(&(bar)[XB_TMO])) break; if (_sp > XB_SPIN_CAP) { atomicAdd(&(bar)[XB_TMO], 1u); break; } } } } while (0)

struct XcdBarrier { unsigned* bar; unsigned x; volatile LAS unsigned* st; };

__device__ __forceinline__ XcdBarrier xcd_barrier_post(unsigned* bar, volatile LAS unsigned* st) {
    XcdBarrier b; b.bar = bar; b.x = xb_xcc_id(); b.st = st;
    if (threadIdx.x == 0) (void)xb_add(&bar[XB_XCNT(b.x)], 1u);
    return b;
}
__device__ __forceinline__ void xcd_barrier_complete(unsigned* bar, unsigned x, unsigned& nloc, unsigned& nx) {
    const unsigned G = gridDim.x * gridDim.y * gridDim.z;
    unsigned sum, cnt, mine, sp = 0u;
    for (;;) {
        sum = 0u; cnt = 0u; mine = 0u;
#pragma unroll
        for (unsigned j = 0; j < 16; ++j) { const unsigned c = xb_ld(&bar[XB_XCNT(j)]); sum += c; cnt += (c > 0u) ? 1u : 0u; mine = (j == x) ? c : mine; }
        if (sum == G) break;
        __builtin_amdgcn_s_sleep(1);
        if ((++sp & 255u) == 0u) { if (xb_ld(&bar[XB_TMO])) break; if (sp > XB_SPIN_CAP) { atomicAdd(&bar[XB_TMO], 1u); break; } }
    }
    nloc = mine > 0u ? mine : 1u; nx = cnt > 0u ? cnt : 1u;
}
__device__ __forceinline__ void xcd_barrier(const XcdBarrier& b, int wv) {
    asm volatile("s_waitcnt vmcnt(0)" ::: "memory");
    __syncthreads();
    if (TIDX(wv) == 0) {
        unsigned* bar = b.bar;
        __builtin_amdgcn_s_waitcnt(0);
        unsigned nloc = b.st[0], nx = b.st[1];
        if (nloc == 0u) { xcd_barrier_complete(bar, b.x, nloc, nx); b.st[0] = nloc; b.st[1] = nx; }
        const unsigned old = xb_add(&bar[XB_XSUB(b.x)], 1u);
        const unsigned gen = old / nloc;
        if (old + 1u == (gen + 1u) * nloc) {
            __builtin_amdgcn_fence(__ATOMIC_RELEASE, "agent");
            asm volatile("s_waitcnt vmcnt(0)" ::: "memory");
            const unsigned og = xb_add(&bar[XB_TOP], 1u);
            const unsigned tg = og / nx;
            if (og + 1u == (tg + 1u) * nx) xb_add(&bar[XB_TOPGEN], 1u);
            else XB_SPIN(xb_ld(&bar[XB_TOPGEN]) == tg, bar);
            __builtin_amdgcn_fence(__ATOMIC_ACQUIRE, "agent");
            xb_add(&bar[XB_XGEN(b.x)], 1u);
            asm volatile("s_waitcnt vmcnt(0)" ::: "memory");
        } else {
            XB_SPIN(xb_ld(&bar[XB_XGEN(b.x)]) == gen, bar);
            __builtin_amdgcn_fence(__ATOMIC_ACQUIRE, "agent");
            asm volatile("s_waitcnt vmcnt(0)" ::: "memory");
        }
    }
    __syncthreads();
}

struct Params { const float* in[30]; float* out; unsigned char* ws; int ph_lo, ph_hi; };
enum { I_X = 0, I_C, I_CTX, I_CCTX, I_WADA, I_BADA, I_WIN, I_AQG, I_AKG, I_RPB, I_CCONV, I_CALOG, I_CDTB, I_COG, I_DGW, I_DGB, I_DOG,
       I_WBR, I_WOUT, I_LN1G, I_LN1B, I_LN2G, I_LN2B, I_WRG, I_BRG, I_WRE, I_BRE, I_WUP, I_WGATE, I_WDOWN };

typedef const __attribute__((address_space(4))) Params* KP;
__device__ __forceinline__ KP kp_get() { KP k = (KP)__builtin_amdgcn_kernarg_segment_ptr(); asm volatile("" : "+s"(k)); return k; }
#if defined(__HIP_DEVICE_COMPILE__)
#define LOADP() const Params q = *kp_get()
#else
#define LOADP() const Params q = p
#endif
__device__ __forceinline__ int opq(int v) { asm volatile("" : "+v"(v)); return v; }
template <int X> __device__ __forceinline__ float shx(float v) { return __int_as_float(__builtin_amdgcn_ds_swizzle(__float_as_int(v), (X << 10) | 0x1f)); }
template <int CTRL> __device__ __forceinline__ float dppf(float v) { return __int_as_float(__builtin_amdgcn_update_dpp(0, __float_as_int(v), CTRL, 0xF, 0xF, true)); }
__device__ __forceinline__ float row16_sum(float v) { v += dppf<0xB1>(v); v += dppf<0x4E>(v); v += dppf<0x141>(v); v += dppf<0x140>(v); return v; }
__device__ __forceinline__ float wave_sum(float v) {
    v = row16_sum(v);
    v += __int_as_float(__builtin_amdgcn_update_dpp(__float_as_int(v), __float_as_int(v), 0x142, 0xA, 0xF, false));
    v += __int_as_float(__builtin_amdgcn_update_dpp(__float_as_int(v), __float_as_int(v), 0x143, 0xC, 0xF, false));
    return __int_as_float(__builtin_amdgcn_readlane(__float_as_int(v), 63));
}
__device__ __forceinline__ float sigm_fast(float x) { return __builtin_amdgcn_rcpf(1.f + __builtin_amdgcn_exp2f(-1.4426950408889634f * x)); }
__device__ __forceinline__ float silu_f(float x) { return x * sigm_fast(x); }
__device__ __forceinline__ float sigm_f(float x) { return sigm_fast(x); }
__device__ __forceinline__ float softplus_f(float x) { return x > 20.f ? x : __logf(1.f + __expf(x)); }
typedef _Float16 h16x4 __attribute__((ext_vector_type(4)));
__device__ __forceinline__ const float* xin_row(const Params& p, int r) { return r < TL ? p.in[I_X] + (size_t)r * D : p.in[I_CTX] + (size_t)(r - TL) * D; }
__device__ __forceinline__ f32x4 ldh4(const _Float16* q) { return __builtin_convertvector(*(const h16x4*)q, f32x4); }
__device__ __forceinline__ void sth4(_Float16* q, const f32x4 v) { *(h16x4*)q = __builtin_convertvector(v, h16x4); }
__device__ __forceinline__ int brow(int r) { return r < TL ? (r >> 11) : 16; }
__device__ __forceinline__ float bf2f(bf16_t v) { return __uint_as_float(((unsigned)v) << 16); }
__device__ __forceinline__ float bflo(unsigned w) { return __uint_as_float(w << 16); }
__device__ __forceinline__ float bfhi(unsigned w) { return __uint_as_float(w & 0xffff0000u); }
__device__ __forceinline__ unsigned f2bf(float f) { unsigned u = __float_as_uint(f); return (u + 0x7fffu + ((u >> 16) & 1u)) >> 16; }
typedef __bf16 bfv2 __attribute__((ext_vector_type(2)));
__device__ __forceinline__ unsigned pk2(float lo, float hi) { const f32x2 v = {lo, hi}; return __builtin_bit_cast(unsigned, __builtin_convertvector(v, bfv2)); }
__device__ __forceinline__ void unpack8(const u32x4 w, float (&f)[8]) { f[0] = bflo(w.x); f[1] = bfhi(w.x); f[2] = bflo(w.y); f[3] = bfhi(w.y); f[4] = bflo(w.z); f[5] = bfhi(w.z); f[6] = bflo(w.w); f[7] = bfhi(w.w); }

namespace pg8 {
#define PG8_LAS __attribute__((address_space(3)))
constexpr int BM = 256, BK = 64, HALF = 128, HTB = HALF * BK * 2, STAGE_BYTES = 8 * HTB, NXCD = 8, WGM = 8;
__host__ __device__ __forceinline__ int lds_byte(int r, int c) { const int st = (r >> 4) * 2 + (c >> 5), rr = r & 15, cc = c & 31, ob = rr * 64 + cc * 2; return st * 1024 + (ob ^ (((ob >> 9) & 1) << 5)); }
__host__ __device__ __forceinline__ void stage_rc(int b, int& R, int& C) { const int st = b / 1024, sb = b % 1024, swz = sb ^ (((sb >> 9) & 1) << 5); R = (st >> 1) * 16 + swz / 64; C = (st & 1) * 32 + (swz % 64) / 2; }
__host__ __device__ __forceinline__ int perm32(int rho) { const int n = rho >> 4, i = rho & 15; return 8 * (i >> 2) + 4 * n + (i & 3); }

struct Unit { int pm, pn, e; };
struct Gemm { const bf16_t* A; const bf16_t* Bt; int M, N, K, lda, ldb; size_t bstride; };

struct StaticOrder {
    int nM, nN, nwg, G, c;
    __device__ void init(int M, int N, int G_, int c_) { nM = M / BM; nN = N / BM; nwg = nM * nN; G = G_; c = c_; }
    __device__ bool next(int i, Unit& u) const {
        const long L = (long)i * G + c; if (L >= nwg) return false;
        int wgid = (int)L; { const int q = nwg / NXCD, r = nwg % NXCD, xcd = wgid % NXCD, off = wgid / NXCD; wgid = (xcd < r ? xcd * (q + 1) : r * (q + 1) + (xcd - r) * q) + off; }
        const int nig = WGM * nN, gid = wgid / nig, fm = gid * WGM, gsz = (nM - fm) < WGM ? (nM - fm) : WGM;
        u.pm = fm + ((wgid % nig) % gsz); u.pn = (wgid % nig) / gsz; u.e = 0; return true;
    }
    __device__ __forceinline__ void a_ready(const Unit&) const {}
    __device__ __forceinline__ void done(const Unit&) const {}
};
struct ExpertOrder {
    int nN, G, c; const PG8_LAS int* ts;
    __device__ bool next(int i, Unit& u) const {
        const int total = ts[32] * nN; const long L = (long)i * G + c; if (L >= total) return false;
        const int mt = (int)L / nN;
        const int ln = (int)__builtin_amdgcn_mbcnt_hi(~0u, __builtin_amdgcn_mbcnt_lo(~0u, 0u)); const int tv = ts[ln & 31];
        const int e = __builtin_popcountll(__builtin_amdgcn_ballot_w64(ln >= 1 && ln < 32 && tv <= mt));
        u.pm = mt; u.pn = (int)L % nN; u.e = e; return true;
    }
    __device__ __forceinline__ void a_ready(const Unit&) const {}
    __device__ __forceinline__ void done(const Unit&) const {}
    const unsigned* cnt; const int* lists;
    __device__ __forceinline__ int entry(const Unit& u, int rit) const { const int off = (u.pm - ts[u.e]) * BM + rit, cn = (int)cnt[u.e];
        const int v = lists[(size_t)u.e * (TT * 2) + (off < cn ? off : cn - 1)]; return off < cn ? v : -1; }
    __device__ __forceinline__ int arow(const Unit& u, int rit) const { const int en = entry(u, rit); return en < 0 ? 0 : (en >> 1); }
};

__device__ __forceinline__ unsigned cvt_pk_bf16(float lo, float hi) { unsigned r; asm volatile("v_cvt_pk_bf16_f32 %0, %1, %2" : "=v"(r) : "v"(lo), "v"(hi)); return r; }
struct EpiStore {
    static constexpr bool PERM = true;
    bf16_t* O; int ldc;
    __device__ __forceinline__ void operator()(const f32x4 (&acc)[2][2][4][2], const Unit& u, int wr, int wc, int fr, int fq) const {
        const int row0 = u.pm * BM + wr * 64 + fr, col0 = u.pn * BM + wc * 32 + 8 * fq;
#pragma unroll
        for (int ai = 0; ai < 2; ++ai)
#pragma unroll
            for (int m = 0; m < 4; ++m) { bf16_t* rowp = O + (size_t)(row0 + ai * HALF + m * 16) * ldc + col0;
#pragma unroll
                for (int bj = 0; bj < 2; ++bj) { const f32x4 v0 = acc[ai][bj][m][0], v1 = acc[ai][bj][m][1];
                    u32x4 w; w.x = cvt_pk_bf16(v0[0], v0[1]); w.y = cvt_pk_bf16(v0[2], v0[3]); w.z = cvt_pk_bf16(v1[0], v1[1]); w.w = cvt_pk_bf16(v1[2], v1[3]);
                    *(u32x4*)(rowp + bj * HALF) = w; } }
    }
};
template <class Sched> struct EpiScatter {
    static constexpr bool PERM = true;
    bf16_t* O; int ldc; const Sched* S;
    __device__ __forceinline__ void operator()(const f32x4 (&acc)[2][2][4][2], const Unit& u, int wr, int wc, int fr, int fq) const {
        const int col0 = u.pn * BM + wc * 32 + 8 * fq;
        int ens[2][4];
#pragma unroll
        for (int ai = 0; ai < 2; ++ai)
#pragma unroll
            for (int m = 0; m < 4; ++m) ens[ai][m] = S->entry(u, wr * 64 + fr + ai * HALF + m * 16);
        __builtin_amdgcn_sched_barrier(0);
#pragma unroll
        for (int ai = 0; ai < 2; ++ai)
#pragma unroll
            for (int m = 0; m < 4; ++m) { const int en = ens[ai][m];
                if (en >= 0) { bf16_t* rowp = O + (size_t)en * ldc + col0;
#pragma unroll
                    for (int bj = 0; bj < 2; ++bj) { const f32x4 v0 = acc[ai][bj][m][0], v1 = acc[ai][bj][m][1];
                        u32x4 w; w.x = cvt_pk_bf16(v0[0], v0[1]); w.y = cvt_pk_bf16(v0[2], v0[3]); w.z = cvt_pk_bf16(v1[0], v1[1]); w.w = cvt_pk_bf16(v1[2], v1[3]);
                        *(u32x4*)(rowp + bj * HALF) = w; } } }
    }
};
struct EpiSwiglu {
    static constexpr bool PERM = true;
    bf16_t* Hd; int ldc;
    __device__ __forceinline__ void operator()(const f32x4 (&acc)[2][2][4][2], const Unit& u, int wr, int wc, int fr, int fq) const {
        const int row0 = u.pm * BM + wr * 64 + fr, col0 = u.pn * HALF + wc * 32 + 8 * fq;
#pragma unroll
        for (int ai = 0; ai < 2; ++ai)
#pragma unroll
            for (int m = 0; m < 4; ++m) { bf16_t* rowp = Hd + (size_t)(row0 + ai * HALF + m * 16) * ldc + col0; float o[8];
#pragma unroll
                for (int n = 0; n < 2; ++n)
#pragma unroll
                    for (int j = 0; j < 4; ++j) { const float gt = acc[ai][0][m][n][j], up = acc[ai][1][m][n][j]; o[n * 4 + j] = gt * sigm_fast(gt) * up; }
                u32x4 w; w.x = cvt_pk_bf16(o[0], o[1]); w.y = cvt_pk_bf16(o[2], o[3]); w.z = cvt_pk_bf16(o[4], o[5]); w.w = cvt_pk_bf16(o[6], o[7]);
                *(u32x4*)rowp = w; }
    }
};

template <class Epi, class Sched>
__device__ __forceinline__ void gemm_phase(PG8_LAS unsigned char* lds, const Gemm g, const Sched& S, const Epi& E, int wv) {
    const int tid = opq(TIDX(wv)), wid = __builtin_amdgcn_readfirstlane(tid >> 6), lane = tid & 63, wr = wid >> 2, wc = wid & 3, fr = lane & 15, fq = lane >> 4;
    const int K = g.K, nt = K / BK;
    unsigned voffA[2], voffB[2];
#pragma unroll
    for (int i = 0; i < 2; ++i) { int R, C; stage_rc(tid * 16 + i * 8192, R, C); const int Rb = Epi::PERM ? ((R & ~31) + perm32(R & 31)) : R;
        voffA[i] = (unsigned)(R * g.lda + C) * 2u; voffB[i] = (unsigned)(Rb * g.ldb + C) * 2u; }
    const size_t kstep = (size_t)(BK * 2);
    const size_t hstepA = (size_t)HALF * g.lda * 2, hstepB = (size_t)HALF * g.ldb * 2;
    const size_t tstepA = 2 * hstepA, tstepB = 2 * hstepB;
    const unsigned ldsw = (unsigned)wid * 1024u;
    const int aoff = lds_byte(wr * 64 + fr, fq * 8), boff = lds_byte(wc * 32 + fr, fq * 8);
#define PG8_SA(b, h) (((b) * 2 + (h)) * HTB)
#define PG8_SB(b, h) ((4 + (b) * 2 + (h)) * HTB)
#define PG8_STAGE(bufoff, gbase, voff) do { _Pragma("unroll") for (int _i = 0; _i < 2; ++_i) \
        __builtin_amdgcn_global_load_lds((const unsigned*)((const char*)(gbase) + (voff)[_i]), (PG8_LAS unsigned*)(lds + (bufoff) + ldsw + _i * 8192), 16, 0, 0); } while (0)
#define PG8_LDA(dst, b, h) do { _Pragma("unroll") for (int m = 0; m < 4; ++m) _Pragma("unroll") for (int k = 0; k < 2; ++k) dst[m][k] = *(const PG8_LAS bf16x8*)(lds + PG8_SA(b, h) + aoff + m * 2048 + k * 1024); } while (0)
#define PG8_LDB(dst, b, h) do { _Pragma("unroll") for (int n = 0; n < 2; ++n) _Pragma("unroll") for (int k = 0; k < 2; ++k) dst[n][k] = *(const PG8_LAS bf16x8*)(lds + PG8_SB(b, h) + boff + n * 2048 + k * 1024); } while (0)
#define PG8_MMA(ai, bj, At, Bt) do { __builtin_amdgcn_s_setprio(1); _Pragma("unroll") for (int m = 0; m < 4; ++m) _Pragma("unroll") for (int n = 0; n < 2; ++n) _Pragma("unroll") for (int k = 0; k < 2; ++k) \
        acc[ai][bj][m][n] = __builtin_amdgcn_mfma_f32_16x16x32_bf16(Bt[n][k], At[m][k], acc[ai][bj][m][n], 0, 0, 0); __builtin_amdgcn_s_setprio(0); } while (0)
#define PG8_WAIT_V(n) asm volatile("s_waitcnt vmcnt(" #n ")" ::: "memory")
#define PG8_WAIT_L(n) asm volatile("s_waitcnt lgkmcnt(" #n ")" ::: "memory")
#define PG8_BAR __builtin_amdgcn_s_barrier()
#define PG8_SCHED __builtin_amdgcn_sched_barrier(0)
    Unit cur, nxt; int ui = 0;
    if (!S.next(0, cur)) return;
    f32x4 acc[2][2][4][2];
#pragma unroll
    for (int a = 0; a < 2; ++a)
#pragma unroll
        for (int b = 0; b < 2; ++b)
#pragma unroll
            for (int m = 0; m < 4; ++m)
#pragma unroll
                for (int n = 0; n < 2; ++n) acc[a][b][m][n] = (f32x4){0.f, 0.f, 0.f, 0.f};
    bf16x8 At[4][2], B0[2][2], B1[2][2];
    const char* cA = (const char*)g.A + (size_t)cur.pm * tstepA; const char* cB = (const char*)g.Bt + (size_t)cur.e * g.bstride * 2 + (size_t)cur.pn * tstepB;
    S.a_ready(cur);
    PG8_STAGE(PG8_SB(0, 0), cB, voffB); PG8_STAGE(PG8_SA(0, 0), cA, voffA); PG8_STAGE(PG8_SB(0, 1), cB + hstepB, voffB); PG8_STAGE(PG8_SA(0, 1), cA + hstepA, voffA);
    if (wr == 1) PG8_BAR;
    PG8_WAIT_V(4); PG8_BAR;
    PG8_STAGE(PG8_SB(1, 0), cB + kstep, voffB); PG8_STAGE(PG8_SA(1, 0), cA + kstep, voffA); PG8_STAGE(PG8_SB(1, 1), cB + hstepB + kstep, voffB);
    PG8_WAIT_V(6); PG8_BAR;
    for (;;) {
        const bool has_next = S.next(ui + 1, nxt);
        const char* nA = has_next ? (const char*)g.A + (size_t)nxt.pm * tstepA : cA;
        const char* nB = has_next ? (const char*)g.Bt + (size_t)nxt.e * g.bstride * 2 + (size_t)nxt.pn * tstepB : cB;
        for (int t = 0; t < nt; t += 2) {
            const bool last = (t == nt - 2);
            const char* a1 = cA + (size_t)(t + 1) * kstep;
            const char* a2 = last ? nA : cA + (size_t)(t + 2) * kstep; const char* b2 = last ? nB : cB + (size_t)(t + 2) * kstep;
            const char* a3 = a2 + kstep; const char* b3 = b2 + kstep;
            if (last && has_next) S.a_ready(nxt);
            PG8_LDB(B0, 0, 0); PG8_SCHED; PG8_LDA(At, 0, 0); PG8_STAGE(PG8_SA(1, 1), a1 + hstepA, voffA);
            PG8_WAIT_L(8); PG8_BAR; PG8_WAIT_L(0); PG8_MMA(0, 0, At, B0); PG8_BAR; PG8_SCHED;
            PG8_LDB(B1, 0, 1); PG8_STAGE(PG8_SB(0, 0), b2, voffB);
            PG8_BAR; PG8_WAIT_L(0); PG8_MMA(0, 1, At, B1); PG8_BAR;
            PG8_LDA(At, 0, 1); PG8_STAGE(PG8_SA(0, 0), a2, voffA);
            PG8_BAR; PG8_WAIT_L(0); PG8_MMA(1, 0, At, B0); PG8_BAR; PG8_SCHED;
            PG8_STAGE(PG8_SB(0, 1), b2 + hstepB, voffB);
            PG8_WAIT_V(6); PG8_BAR; PG8_MMA(1, 1, At, B1); PG8_BAR;
            PG8_LDB(B0, 1, 0); PG8_SCHED; PG8_LDA(At, 1, 0); PG8_STAGE(PG8_SA(0, 1), a2 + hstepA, voffA);
            PG8_WAIT_L(8); PG8_BAR; PG8_WAIT_L(0); PG8_MMA(0, 0, At, B0); PG8_BAR; PG8_SCHED;
            PG8_LDB(B1, 1, 1); PG8_STAGE(PG8_SB(1, 0), b3, voffB);
            PG8_BAR; PG8_WAIT_L(0); PG8_MMA(0, 1, At, B1); PG8_BAR;
            PG8_LDA(At, 1, 1); PG8_STAGE(PG8_SA(1, 0), a3, voffA);
            PG8_BAR; PG8_WAIT_L(0); PG8_MMA(1, 0, At, B0); PG8_BAR; PG8_SCHED;
            PG8_STAGE(PG8_SB(1, 1), b3 + hstepB, voffB);
            PG8_WAIT_V(6); PG8_BAR; PG8_MMA(1, 1, At, B1); PG8_BAR;
        }
        E(acc, cur, wr, wc, fr, fq); S.done(cur);
        if (!has_next) break;
#pragma unroll
        for (int a = 0; a < 2; ++a)
#pragma unroll
            for (int b = 0; b < 2; ++b)
#pragma unroll
                for (int m = 0; m < 4; ++m)
#pragma unroll
                    for (int n = 0; n < 2; ++n) acc[a][b][m][n] = (f32x4){0.f, 0.f, 0.f, 0.f};
        cur = nxt; cA = nA; cB = nB; ++ui;
    }
    PG8_WAIT_V(0);
    if (wr == 0) PG8_BAR;
    PG8_BAR;
#undef PG8_SA
#undef PG8_SB
#undef PG8_STAGE
#undef PG8_LDA
#undef PG8_LDB
#undef PG8_MMA
#undef PG8_WAIT_V
#undef PG8_WAIT_L
#undef PG8_BAR
#undef PG8_SCHED
}

template <class Epi, class Sched>
__device__ __forceinline__ void gemm_phase_gather(PG8_LAS unsigned char* lds, const Gemm g, const Sched& S, const Epi& E, int wv) {
    const int tid = opq(TIDX(wv)), wid = __builtin_amdgcn_readfirstlane(tid >> 6), lane = tid & 63, wr = wid >> 2, wc = wid & 3, fr = lane & 15, fq = lane >> 4;
    const int K = g.K, nt = K / BK;
    int RA0, CA0; stage_rc(tid * 16, RA0, CA0);
    const unsigned voffB0 = (unsigned)((Epi::PERM ? ((RA0 & ~31) + perm32(RA0 & 31)) : RA0) * g.ldb + CA0) * 2u;
    const size_t pstepB = (size_t)64 * g.ldb * 2;
    unsigned vA[2][2], nvA[2][2];
#define PG8_ROWOFF(dst, u_) do { _Pragma("unroll") for (int h_ = 0; h_ < 2; ++h_) _Pragma("unroll") for (int i_ = 0; i_ < 2; ++i_) \
        dst[h_][i_] = (unsigned)(S.arow(u_, h_ * HALF + RA0 + 64 * i_) * g.lda + CA0) * 2u; } while (0)
    const size_t kstep = (size_t)(BK * 2);
    const size_t hstepB = (size_t)HALF * g.ldb * 2;
    const size_t tstepB = 2 * hstepB;
    const unsigned ldsw = (unsigned)wid * 1024u;
    const int aoff = lds_byte(wr * 64 + fr, fq * 8), boff = lds_byte(wc * 32 + fr, fq * 8);
#define PG8_SA(b, h) (((b) * 2 + (h)) * HTB)
#define PG8_SB(b, h) ((4 + (b) * 2 + (h)) * HTB)
#define PG8_STAGE(bufoff, gbase, voff) do { _Pragma("unroll") for (int _i = 0; _i < 2; ++_i) \
        __builtin_amdgcn_global_load_lds((const unsigned*)((const char*)(gbase) + (voff)[_i]), (PG8_LAS unsigned*)(lds + (bufoff) + ldsw + _i * 8192), 16, 0, 0); } while (0)
#define PG8_STAGEB(bufoff, gbase) do { _Pragma("unroll") for (int _i = 0; _i < 2; ++_i) \
        __builtin_amdgcn_global_load_lds((const unsigned*)((const char*)(gbase) + _i * pstepB + voffB0), (PG8_LAS unsigned*)(lds + (bufoff) + ldsw + _i * 8192), 16, 0, 0); } while (0)
#define PG8_LDA(dst, b, h) do { _Pragma("unroll") for (int m = 0; m < 4; ++m) _Pragma("unroll") for (int k = 0; k < 2; ++k) dst[m][k] = *(const PG8_LAS bf16x8*)(lds + PG8_SA(b, h) + aoff + m * 2048 + k * 1024); } while (0)
#define PG8_LDB(dst, b, h) do { _Pragma("unroll") for (int n = 0; n < 2; ++n) _Pragma("unroll") for (int k = 0; k < 2; ++k) dst[n][k] = *(const PG8_LAS bf16x8*)(lds + PG8_SB(b, h) + boff + n * 2048 + k * 1024); } while (0)
#define PG8_MMA(ai, bj, At, Bt) do { __builtin_amdgcn_s_setprio(1); _Pragma("unroll") for (int m = 0; m < 4; ++m) _Pragma("unroll") for (int n = 0; n < 2; ++n) _Pragma("unroll") for (int k = 0; k < 2; ++k) \
        acc[ai][bj][m][n] = __builtin_amdgcn_mfma_f32_16x16x32_bf16(Bt[n][k], At[m][k], acc[ai][bj][m][n], 0, 0, 0); __builtin_amdgcn_s_setprio(0); } while (0)
#define PG8_WAIT_V(n) asm volatile("s_waitcnt vmcnt(" #n ")" ::: "memory")
#define PG8_WAIT_L(n) asm volatile("s_waitcnt lgkmcnt(" #n ")" ::: "memory")
#define PG8_BAR __builtin_amdgcn_s_barrier()
#define PG8_SCHED __builtin_amdgcn_sched_barrier(0)
    Unit cur, nxt; int ui = 0;
    if (!S.next(0, cur)) return;
    f32x4 acc[2][2][4][2];
#pragma unroll
    for (int a = 0; a < 2; ++a)
#pragma unroll
        for (int b = 0; b < 2; ++b)
#pragma unroll
            for (int m = 0; m < 4; ++m)
#pragma unroll
                for (int n = 0; n < 2; ++n) acc[a][b][m][n] = (f32x4){0.f, 0.f, 0.f, 0.f};
    bf16x8 At[4][2], B0[2][2], B1[2][2];
    const char* cA = (const char*)g.A; PG8_ROWOFF(vA, cur); const char* cB = (const char*)g.Bt + (size_t)cur.e * g.bstride * 2 + (size_t)cur.pn * tstepB;
    S.a_ready(cur);
    PG8_STAGEB(PG8_SB(0, 0), cB); PG8_STAGE(PG8_SA(0, 0), cA, vA[0]); PG8_STAGEB(PG8_SB(0, 1), cB + hstepB); PG8_STAGE(PG8_SA(0, 1), cA, vA[1]);
    if (wr == 1) PG8_BAR;
    PG8_WAIT_V(4); PG8_BAR;
    PG8_STAGEB(PG8_SB(1, 0), cB + kstep); PG8_STAGE(PG8_SA(1, 0), cA + kstep, vA[0]); PG8_STAGEB(PG8_SB(1, 1), cB + hstepB + kstep);
    PG8_WAIT_V(6); PG8_BAR;
    for (;;) {
        const bool has_next = S.next(ui + 1, nxt);
        if (has_next) PG8_ROWOFF(nvA, nxt); else { nvA[0][0] = vA[0][0]; nvA[0][1] = vA[0][1]; nvA[1][0] = vA[1][0]; nvA[1][1] = vA[1][1]; }
        const char* nB = has_next ? (const char*)g.Bt + (size_t)nxt.e * g.bstride * 2 + (size_t)nxt.pn * tstepB : cB;
        for (int t = 0; t < nt; t += 2) {
            const bool last = (t == nt - 2);
            const char* a1 = cA + (size_t)(t + 1) * kstep;
            const char* a2 = last ? cA : cA + (size_t)(t + 2) * kstep; const char* b2 = last ? nB : cB + (size_t)(t + 2) * kstep;
            const char* a3 = a2 + kstep; const char* b3 = b2 + kstep;
            if (last && has_next) S.a_ready(nxt);
            PG8_LDB(B0, 0, 0); PG8_SCHED; PG8_LDA(At, 0, 0); PG8_STAGE(PG8_SA(1, 1), a1, vA[1]);
            PG8_WAIT_L(8); PG8_BAR; PG8_WAIT_L(0); PG8_MMA(0, 0, At, B0); PG8_BAR; PG8_SCHED;
            PG8_LDB(B1, 0, 1); PG8_STAGEB(PG8_SB(0, 0), b2);
            PG8_BAR; PG8_WAIT_L(0); PG8_MMA(0, 1, At, B1); PG8_BAR;
            PG8_LDA(At, 0, 1); if (last) PG8_STAGE(PG8_SA(0, 0), a2, nvA[0]); else PG8_STAGE(PG8_SA(0, 0), a2, vA[0]);
            PG8_BAR; PG8_WAIT_L(0); PG8_MMA(1, 0, At, B0); PG8_BAR; PG8_SCHED;
            PG8_STAGEB(PG8_SB(0, 1), b2 + hstepB);
            PG8_WAIT_V(6); PG8_BAR; PG8_MMA(1, 1, At, B1); PG8_BAR;
            PG8_LDB(B0, 1, 0); PG8_SCHED; PG8_LDA(At, 1, 0); if (last) PG8_STAGE(PG8_SA(0, 1), a2, nvA[1]); else PG8_STAGE(PG8_SA(0, 1), a2, vA[1]);
            PG8_WAIT_L(8); PG8_BAR; PG8_WAIT_L(0); PG8_MMA(0, 0, At, B0); PG8_BAR; PG8_SCHED;
            PG8_LDB(B1, 1, 1); PG8_STAGEB(PG8_SB(1, 0), b3);
            PG8_BAR; PG8_WAIT_L(0); PG8_MMA(0, 1, At, B1); PG8_BAR;
            PG8_LDA(At, 1, 1); if (last) PG8_STAGE(PG8_SA(1, 0), a3, nvA[0]); else PG8_STAGE(PG8_SA(1, 0), a3, vA[0]);
            PG8_BAR; PG8_WAIT_L(0); PG8_MMA(1, 0, At, B0); PG8_BAR; PG8_SCHED;
            PG8_STAGEB(PG8_SB(1, 1), b3 + hstepB);
            PG8_WAIT_V(6); PG8_BAR; PG8_MMA(1, 1, At, B1); PG8_BAR;
        }
        { const int l2_ = TIDX(wv) & 63; E(acc, cur, wr, wc, l2_ & 15, l2_ >> 4); } S.done(cur);
        if (!has_next) break;
#pragma unroll
        for (int a = 0; a < 2; ++a)
#pragma unroll
            for (int b = 0; b < 2; ++b)
#pragma unroll
                for (int m = 0; m < 4; ++m)
#pragma unroll
                    for (int n = 0; n < 2; ++n) acc[a][b][m][n] = (f32x4){0.f, 0.f, 0.f, 0.f};
        cur = nxt; cB = nB; ++ui; vA[0][0] = nvA[0][0]; vA[0][1] = nvA[0][1]; vA[1][0] = nvA[1][0]; vA[1][1] = nvA[1][1];
    }
    PG8_WAIT_V(0);
    if (wr == 0) PG8_BAR;
    PG8_BAR;
#undef PG8_ROWOFF
#undef PG8_SA
#undef PG8_SB
#undef PG8_STAGE
#undef PG8_STAGEB
#undef PG8_LDA
#undef PG8_LDB
#undef PG8_MMA
#undef PG8_WAIT_V
#undef PG8_WAIT_L
#undef PG8_BAR
#undef PG8_SCHED
}

struct GatedMerge { const bf16_t* A; const bf16_t* Bt; const bf16_t* G; int ldg; bf16_t* Mg; int M; };
__device__ __forceinline__ void gemm_gated_phase(PG8_LAS unsigned char* lds, const GatedMerge g, int G_, int c_, int wv) {
    const int tid = opq(TIDX(wv)), wid = __builtin_amdgcn_readfirstlane(tid >> 6), lane = tid & 63, wr = wid >> 2, wc = wid & 3, fr = lane & 15, fq = lane >> 4;
    constexpr int K = 1024, nt = K / BK, NT = 8;
    const int nM = g.M / BM, nunits = nM * NT;
    unsigned voffA[2], voffB[2];
#pragma unroll
    for (int i = 0; i < 2; ++i) { int R, C; stage_rc(tid * 16 + i * 8192, R, C); const int Rb = (R & ~31) + perm32(R & 31);
        voffA[i] = (unsigned)(R * K + C) * 2u; voffB[i] = (unsigned)(Rb * K + C) * 2u; }
    const size_t kstep = (size_t)(BK * 2), hstepA = (size_t)HALF * K * 2, tstepA = 2 * hstepA, tstepB = (size_t)HALF * K * 2;
    const unsigned ldsw = (unsigned)wid * 1024u;
    const int aoff = lds_byte(wr * 64 + fr, fq * 8), boff = lds_byte(wc * 32 + fr, fq * 8);
#define PG8_SA(b, h) (((b) * 2 + (h)) * HTB)
#define PG8_SB(b, h) ((4 + (b) * 2 + (h)) * HTB)
#define PG8_STAGE(bufoff, gbase, voff) do { _Pragma("unroll") for (int _i = 0; _i < 2; ++_i) \
        __builtin_amdgcn_global_load_lds((const unsigned*)((const char*)(gbase) + (voff)[_i]), (PG8_LAS unsigned*)(lds + (bufoff) + ldsw + _i * 8192), 16, 0, 0); } while (0)
#define PG8_LDA(dst, b, h) do { _Pragma("unroll") for (int m = 0; m < 4; ++m) _Pragma("unroll") for (int k = 0; k < 2; ++k) dst[m][k] = *(const PG8_LAS bf16x8*)(lds + PG8_SA(b, h) + aoff + m * 2048 + k * 1024); } while (0)
#define PG8_LDB(dst, b, h) do { _Pragma("unroll") for (int n = 0; n < 2; ++n) _Pragma("unroll") for (int k = 0; k < 2; ++k) dst[n][k] = *(const PG8_LAS bf16x8*)(lds + PG8_SB(b, h) + boff + n * 2048 + k * 1024); } while (0)
#define PG8_MMA(ai, At, Bt) do { __builtin_amdgcn_s_setprio(1); _Pragma("unroll") for (int m = 0; m < 4; ++m) _Pragma("unroll") for (int n = 0; n < 2; ++n) _Pragma("unroll") for (int k = 0; k < 2; ++k) \
        acc[ai][m][n] = __builtin_amdgcn_mfma_f32_16x16x32_bf16(Bt[n][k], At[m][k], acc[ai][m][n], 0, 0, 0); __builtin_amdgcn_s_setprio(0); } while (0)
#define PG8_WAIT_V(n) asm volatile("s_waitcnt vmcnt(" #n ")" ::: "memory")
#define PG8_WAIT_L(n) asm volatile("s_waitcnt lgkmcnt(" #n ")" ::: "memory")
#define PG8_BAR __builtin_amdgcn_s_barrier()
#define PG8_SCHED __builtin_amdgcn_sched_barrier(0)
    int ui = 0; long L = c_;
    if (L >= nunits) return;
    int pm = (int)(L / NT), pn = (int)(L % NT);
    f32x4 acc[2][4][2], tot[2][4][2];
#pragma unroll
    for (int a = 0; a < 2; ++a)
#pragma unroll
        for (int m = 0; m < 4; ++m)
#pragma unroll
            for (int n = 0; n < 2; ++n) { acc[a][m][n] = (f32x4){0.f, 0.f, 0.f, 0.f}; tot[a][m][n] = (f32x4){0.f, 0.f, 0.f, 0.f}; }
    bf16x8 At[4][2], B0[2][2];
    u32x4 gq0[4], gq1[4];
    const char* cA = (const char*)g.A + (size_t)pm * tstepA; const char* cB = (const char*)g.Bt + (size_t)pn * tstepB;
#define GM_GOFF(z_) ((unsigned)(((pm * BM + wr * 64 + fr) * NPAD + (z_) * 1024 + pn * HALF + wc * 32 + 8 * fq) * 2))
#define GM_GLOAD0(z_) do { const unsigned go_ = GM_GOFF(z_); _Pragma("unroll") for (int m = 0; m < 4; ++m) gq0[m] = *(const u32x4*)((const char*)g.G + (go_ + (unsigned)((m * 16) * NPAD * 2))); } while (0)
#define GM_GLOAD1(z_) do { const unsigned go_ = GM_GOFF(z_); _Pragma("unroll") for (int m = 0; m < 4; ++m) gq1[m] = *(const u32x4*)((const char*)g.G + (go_ + (unsigned)((HALF + m * 16) * NPAD * 2))); } while (0)
    PG8_STAGE(PG8_SB(0, 0), cB, voffB); PG8_STAGE(PG8_SA(0, 0), cA, voffA); PG8_STAGE(PG8_SA(0, 1), cA + hstepA, voffA);
    if (wr == 1) PG8_BAR;
    PG8_WAIT_V(2); PG8_BAR;
    PG8_STAGE(PG8_SB(1, 0), cB + kstep, voffB); PG8_STAGE(PG8_SA(1, 0), cA + kstep, voffA);
    PG8_WAIT_V(4); PG8_BAR;
    GM_GLOAD0(0);
    for (;;) {
        const long Ln = (long)(ui + 1) * G_ + c_; const bool has_next = Ln < nunits;
        const int npm = has_next ? (int)(Ln / NT) : pm, npn = has_next ? (int)(Ln % NT) : pn;
        const char* nA = (const char*)g.A + (size_t)npm * tstepA; const char* nB = (const char*)g.Bt + (size_t)npn * tstepB;
        for (int t = 0; t < nt; t += 2) {
            const bool last = (t == nt - 2);
            const char* a1 = cA + (size_t)(t + 1) * kstep;
            const char* a2 = last ? nA : cA + (size_t)(t + 2) * kstep; const char* b2 = last ? nB : cB + (size_t)(t + 2) * kstep;
            const char* a3 = a2 + kstep; const char* b3 = b2 + kstep;
            PG8_LDB(B0, 0, 0); PG8_SCHED; PG8_LDA(At, 0, 0); PG8_STAGE(PG8_SA(1, 1), a1 + hstepA, voffA);
            PG8_WAIT_L(8); PG8_BAR; PG8_WAIT_L(0); PG8_MMA(0, At, B0); PG8_BAR; PG8_SCHED;
            PG8_STAGE(PG8_SB(0, 0), b2, voffB);
            PG8_BAR; PG8_BAR;
            PG8_LDA(At, 0, 1); PG8_STAGE(PG8_SA(0, 0), a2, voffA);
            PG8_BAR; PG8_WAIT_L(0); PG8_MMA(1, At, B0); PG8_BAR; PG8_SCHED;
            PG8_WAIT_V(4); PG8_BAR; PG8_BAR;
            PG8_LDB(B0, 1, 0); PG8_SCHED; PG8_LDA(At, 1, 0); PG8_STAGE(PG8_SA(0, 1), a2 + hstepA, voffA);
            PG8_WAIT_L(8); PG8_BAR; PG8_WAIT_L(0); PG8_MMA(0, At, B0); PG8_BAR; PG8_SCHED;
            PG8_STAGE(PG8_SB(1, 0), b3, voffB);
            PG8_BAR; PG8_BAR;
            PG8_LDA(At, 1, 1); PG8_STAGE(PG8_SA(1, 0), a3, voffA);
            PG8_BAR; PG8_WAIT_L(0); PG8_MMA(1, At, B0); PG8_BAR; PG8_SCHED;
            PG8_WAIT_V(4); PG8_BAR; PG8_BAR;
            if ((t & 2) != 0) {
                const int z = t >> 2;
                GM_GLOAD1(z);
#pragma unroll
                for (int ai = 0; ai < 2; ++ai)
#pragma unroll
                    for (int m = 0; m < 4; ++m) { float gv[8]; unpack8(ai ? gq1[m] : gq0[m], gv);
#pragma unroll
                        for (int j = 0; j < 4; ++j) { tot[ai][m][0][j] += sigm_fast(gv[j]) * acc[ai][m][0][j]; tot[ai][m][1][j] += sigm_fast(gv[4 + j]) * acc[ai][m][1][j]; }
                        acc[ai][m][0] = (f32x4){0.f, 0.f, 0.f, 0.f}; acc[ai][m][1] = (f32x4){0.f, 0.f, 0.f, 0.f}; }
                if (z < 3) { GM_GLOAD0(z + 1); }
                else {
                    const unsigned oo = (unsigned)(((pm * BM + wr * 64 + fr) * 1024 + pn * HALF + wc * 32 + 8 * fq) * 2);
#pragma unroll
                    for (int ai = 0; ai < 2; ++ai)
#pragma unroll
                        for (int m = 0; m < 4; ++m) { const f32x4 v0 = tot[ai][m][0], v1 = tot[ai][m][1];
                            u32x4 w; w.x = cvt_pk_bf16(v0[0], v0[1]); w.y = cvt_pk_bf16(v0[2], v0[3]); w.z = cvt_pk_bf16(v1[0], v1[1]); w.w = cvt_pk_bf16(v1[2], v1[3]);
                            *(u32x4*)((char*)g.Mg + (oo + (unsigned)((ai * HALF + m * 16) * 1024 * 2))) = w;
                            tot[ai][m][0] = (f32x4){0.f, 0.f, 0.f, 0.f}; tot[ai][m][1] = (f32x4){0.f, 0.f, 0.f, 0.f}; }
                    if (has_next) { pm = npm; pn = npn; GM_GLOAD0(0); }
                }
            }
        }
        if (!has_next) break;
        cA = nA; cB = nB; ++ui;
    }
    PG8_WAIT_V(0);
    if (wr == 0) PG8_BAR;
    PG8_BAR;
#undef GM_GLOAD0
#undef GM_GLOAD1
#undef GM_GOFF
#undef PG8_SA
#undef PG8_SB
#undef PG8_STAGE
#undef PG8_LDA
#undef PG8_LDB
#undef PG8_MMA
#undef PG8_WAIT_V
#undef PG8_WAIT_L
#undef PG8_BAR
#undef PG8_SCHED
}
}

__device__ __forceinline__ void ph_init(const Params& p, float* lds, int bid, int nb, int wv) {
    const int tid = opq(TIDX(wv)), lane = tid & 63, wave = tid >> 6;
    if (bid == 0) {
        float* rt = (float*)(p.ws + WS_WT + 512 * 1024);
        for (int i = tid; i < 1024; i += NTHR) { const int pos = i >> 4, f = i & 15;
            const double inv = (double)powf(10000.f, -(float)f / 16.f); const float ang = (float)pos * (float)inv;
            rt[i] = (float)cos((double)ang); rt[1024 + i] = (float)sin((double)ang); }
    }
    float* sc = lds;
    float* red = lds + 17 * 1024;
    if (bid < 384) {
        {   float cv_[34];
#pragma unroll
            for (int j = 0; j < 34; ++j) { const int i = tid + j * NTHR, b = i >> 10, k = i & 1023; cv_[j] = b < 16 ? p.in[I_C][b * 1024 + k] : p.in[I_CCTX][k]; }
            __builtin_amdgcn_sched_barrier(0);
#pragma unroll
            for (int j = 0; j < 34; ++j) sc[tid + j * NTHR] = silu_f(cv_[j]); }
        __syncthreads();
    }
    float* mod = (float*)(p.ws + WS_MOD);
    for (int it = bid; it < 384; it += nb) {
        const int l = it / 96, cg = it % 96, col = cg * 64 + lane;
        const float* w = p.in[I_WADA] + (size_t)l * D * 6144;
        float acc[17];
#pragma unroll
        for (int b = 0; b < 17; ++b) acc[b] = 0.f;
        for (int k0 = wave * 128; k0 < wave * 128 + 128; k0 += 32) { float wv_[32];
#pragma unroll
            for (int i = 0; i < 32; ++i) wv_[i] = w[(size_t)(k0 + i) * 6144 + col];
            __builtin_amdgcn_sched_barrier(0);
#pragma unroll
            for (int i = 0; i < 32; ++i)
#pragma unroll
                for (int b = 0; b < 17; ++b) acc[b] += sc[b * 1024 + k0 + i] * wv_[i];
            __builtin_amdgcn_sched_barrier(0); }
#pragma unroll
        for (int b = 0; b < 17; ++b) red[(wave * 17 + b) * 64 + lane] = acc[b];
        __syncthreads();
        for (int i = tid; i < 17 * 64; i += NTHR) { const int b = i >> 6, c = i & 63; float s = 0.f;
#pragma unroll
            for (int w8 = 0; w8 < 8; ++w8) s += red[(w8 * 17 + b) * 64 + c];
            mod[((size_t)l * 17 + b) * 6144 + cg * 64 + c] = s + p.in[I_BADA][l * 6144 + cg * 64 + c]; }
        __syncthreads();
    }
}

__device__ __forceinline__ void wconv_item(const float* W, int ldw, int N, bf16_t* WT, int ldt, int k0, int n0, int row_out0, float* scr, int lane) {
    const int nn = lane & 31; const bool ok = n0 + nn < N;
    float wv_[32];
#pragma unroll
    for (int i = 0; i < 32; ++i) { const int kk = 2 * i + (lane >> 5); wv_[i] = ok ? W[(size_t)(k0 + kk) * ldw + n0 + nn] : 0.f; }
#pragma unroll
    for (int i = 0; i < 32; ++i) { const int kk = 2 * i + (lane >> 5); scr[kk * 33 + nn] = wv_[i]; }
    asm volatile("s_waitcnt lgkmcnt(0)" ::: "memory"); __builtin_amdgcn_wave_barrier();
    const int c = lane & 7;
#pragma unroll
    for (int j = 0; j < 4; ++j) { const int n = (lane >> 3) + 8 * j; const float* s = scr + (8 * c) * 33 + n;
        u32x4 o; o.x = pk2(s[0 * 33], s[1 * 33]); o.y = pk2(s[2 * 33], s[3 * 33]); o.z = pk2(s[4 * 33], s[5 * 33]); o.w = pk2(s[6 * 33], s[7 * 33]);
        *(u32x4*)(WT + (size_t)(row_out0 + n) * ldt + k0 + 8 * c) = o; }
    asm volatile("s_waitcnt lgkmcnt(0)" ::: "memory"); __builtin_amdgcn_wave_barrier();
}
constexpr int WI0 = 16 * 226, WI1 = WI0 + 512, WI2 = WI1 + 512, WI3 = WI2 + 8192, WI4 = WI3 + 8192, WI5 = WI4 + 8192;
__device__ __forceinline__ void wconv_wave_item(const Params& p, int l, int it, float* scr, int lane) {
    unsigned char* wb = p.ws + WS_W;
    if (it < WI0) { const int kb = it / 226, nbk = it % 226;
        wconv_item(p.in[I_WIN] + (size_t)l * D * INW, INW, INW, (bf16_t*)(wb + W_IN), 1024, kb * 64, nbk * 32, nbk * 32, scr, lane); }
    else if (it < WI1) { const int r = it - WI0, z = r >> 7, kb = (r & 127) >> 5, nbk = r & 31;
        wconv_item(p.in[I_WBR] + ((size_t)l * 4 + z) * 256 * D, D, D, (bf16_t*)(wb + W_BR) + (size_t)z * 256, 1024, kb * 64, nbk * 32, nbk * 32, scr, lane); }
    else if (it < WI2) { const int r = it - WI1, kb = r >> 5, nbk = r & 31;
        wconv_item(p.in[I_WOUT] + (size_t)l * D * D, D, D, (bf16_t*)(wb + W_OUT), 1024, kb * 64, nbk * 32, nbk * 32, scr, lane); }
    else if (it < WI4) { const int up = it >= WI3, r = it - (up ? WI3 : WI2), e = r >> 8, kb = (r & 255) >> 4, nbk = r & 15, n0 = nbk * 32;
        wconv_item((up ? p.in[I_WUP] : p.in[I_WGATE]) + ((size_t)l * NEXP + e) * D * EH, EH, EH, (bf16_t*)(wb + W_GU) + (size_t)e * 1024 * 1024, 1024, kb * 64, n0,
                   (n0 >> 7) * 256 + (n0 & 127) + up * 128, scr, lane); }
    else { const int r = it - WI4, e = r >> 8, kb = (r & 255) >> 5, nbk = r & 31;
        wconv_item(p.in[I_WDOWN] + ((size_t)l * NEXP + e) * EH * D, D, D, (bf16_t*)(wb + W_DN) + (size_t)e * 1024 * 512, 512, kb * 64, nbk * 32, nbk * 32, scr, lane); }
}
__device__ __forceinline__ void router_relayout(const Params& p, int l, int tid) {
    float* RE = (float*)(p.ws + WS_W + W_RE); float* RG = (float*)(p.ws + WS_W + W_RG);
    const float* wre = p.in[I_WRE] + (size_t)l * 4 * D * 8; const float* wrg = p.in[I_WRG] + (size_t)l * D * 4;
    for (int i = tid; i < 4 * 1024 * 8 + 1024 * 4; i += NTHR) {
        if (i < 32768) { const int k = i & 7, ln = (i >> 3) & 63, e = (i >> 9) & 3, j = (i >> 11) & 3, g = i >> 13; RE[i] = wre[((size_t)g * D + j * 256 + ln * 4 + e) * 8 + k]; }
        else { const int i2 = i - 32768, g = i2 & 3, ln = (i2 >> 2) & 63, e = (i2 >> 8) & 3, j = i2 >> 10; RG[i2] = wrg[(size_t)(j * 256 + ln * 4 + e) * 4 + g]; } }
}
__device__ __forceinline__ void ph_wconv_mod(const Params& p, int l, float* lds, int bid, int nb, int wv) {
    const int tid = opq(TIDX(wv)), lane = tid & 63, wave = tid >> 6;
    const int gw = bid * 8 + wave, NGW = nb * 8;
    float* scr = lds + wave * 2112;
    if (l == 0) for (int it = gw; it < WI0; it += NGW) wconv_wave_item(p, 0, it, scr, lane);
    const float* mod = (const float*)(p.ws + WS_MOD) + (size_t)l * 17 * 6144;
    bf16_t* H = (bf16_t*)(p.ws + WS_H);
    for (int r0 = gw; r0 < TT; r0 += 2 * NGW) {
        f32x4 xv_[2][4], s1_[2][4], sh_[2][4];
#pragma unroll
        for (int q = 0; q < 2; ++q) { const int r = (r0 + q * NGW < TT) ? r0 + q * NGW : r0; const float* xr = xin_row(p, r); const float* m = mod + (size_t)brow(r) * 6144;
#pragma unroll
            for (int j = 0; j < 4; ++j) { const int c = j * 256 + lane * 4; xv_[q][j] = *(const f32x4*)(xr + c); s1_[q][j] = *(const f32x4*)(m + 1024 + c); sh_[q][j] = *(const f32x4*)(m + c); } }
        __builtin_amdgcn_sched_barrier(0);
#pragma unroll
        for (int q = 0; q < 2; ++q) { const int r = r0 + q * NGW; if (r < TT) {
#pragma unroll
            for (int j = 0; j < 4; ++j) { const int c = j * 256 + lane * 4; const f32x4 xv = xv_[q][j], s1 = s1_[q][j], sh = sh_[q][j];
                u32x2 o; o.x = pk2(xv[0] * (1.f + s1[0]) + sh[0], xv[1] * (1.f + s1[1]) + sh[1]); o.y = pk2(xv[2] * (1.f + s1[2]) + sh[2], xv[3] * (1.f + s1[3]) + sh[3]);
                *(u32x2*)(H + (size_t)r * D + c) = o;
                sth4((_Float16*)p.out + (size_t)r * D + c, xv); } } }
    }
}

__device__ __forceinline__ void ph_prep(const Params& p, int l, int bid, int nb, int wv, int dry = 0) {
    const int tid = opq(TIDX(wv)), lane = tid & 63, wave = tid >> 6;
    bf16_t* P = (bf16_t*)(p.ws + WS_P);
    bf16_t* CQ = (bf16_t*)(p.ws + WS_X + X_CQ);
    _Float16* LA = (_Float16*)(p.ws + WS_X + X_LA);
    float* GB = (float*)(p.ws + WS_GB);
    const float* rt = (const float*)(p.ws + WS_WT + 512 * 1024);
    const float* qg = p.in[I_AQG] + l * 64; const float* kg = p.in[I_AKG] + l * 64;
    const float* cw = p.in[I_CCONV] + (size_t)l * 3 * 768;
    float gwr[4][16], gbr[4];
    { const float* gw = p.in[I_DGW] + (size_t)l * 2 * 16 * 128; const float* gb = p.in[I_DGB] + l * 256;
#pragma unroll
        for (int q4 = 0; q4 < 4; ++q4) { const int idx = q4 * 64 + lane, zz = idx >> 7, k = idx & 127; gbr[q4] = gb[zz * 128 + k];
#pragma unroll
            for (int rr = 0; rr < 16; ++rr) gwr[q4][rr] = gw[(zz * 16 + rr) * 128 + k]; } }
    const int l16 = lane & 15, hsel = lane >> 4;
    const f32x4 qg4 = *(const f32x4*)(qg + 4 * l16) * (0.125f * 1.4426950408889634f), kg4 = *(const f32x4*)(kg + 4 * l16);
    f32x4 cwr[3][3];
#pragma unroll
    for (int j = 0; j < 3; ++j)
#pragma unroll
        for (int t = 0; t < 3; ++t) cwr[j][t] = *(const f32x4*)(cw + t * 768 + j * 256 + 4 * lane);
    for (int r = bid * 8 + wave; r < TT; r += nb * 8) {
        bf16_t* pr = P + (size_t)r * NPAD;
        const bool lat = r < TL;
        {
            const int t = r & 2047, gr = t >> 6, gc = t & 63;
            const int pos = (l16 >> 3) ? gc : gr;
            const f32x4 cs = *(const f32x4*)(rt + pos * 16 + 4 * (l16 & 3)), sn = *(const f32x4*)(rt + 1024 + pos * 16 + 4 * (l16 & 3));
            const bool first = (l16 & 4) == 0;
            const u32x2 wq = *(const u32x2*)(pr + 4 * lane), wk = *(const u32x2*)(pr + 256 + 4 * (lane & 31));
#pragma unroll
            for (int part = 0; part < 2; ++part) { const u32x2 w = part ? wk : wq; const f32x4 gn = part ? kg4 : qg4;
                float v[4] = {bflo(w.x), bfhi(w.x), bflo(w.y), bfhi(w.y)};
                float ss = (v[0] * v[0] + v[1] * v[1]) + (v[2] * v[2] + v[3] * v[3]);
                ss = row16_sum(ss);
                const float rn = rsqrtf(ss * (1.f / 64.f) + EPS); float y[4], yp[4];
#pragma unroll
                for (int e = 0; e < 4; ++e) y[e] = v[e] * rn * gn[e];
#pragma unroll
                for (int e = 0; e < 4; ++e) yp[e] = shx<4>(y[e]);
                if (lat) {
#pragma unroll
                    for (int e = 0; e < 4; ++e) y[e] = first ? (y[e] * cs[e] - yp[e] * sn[e]) : (yp[e] * sn[e] + y[e] * cs[e]); }
                u32x2 o; o.x = pk2(y[0], y[1]); o.y = pk2(y[2], y[3]);
                bf16_t* dst = (dry ? (bf16_t*)(p.ws + WS_CM) + (size_t)(r & 4095) * NPAD : pr) + (part ? 256 + 4 * (lane & 31) : 4 * lane);
                if (part == 0 || lane < 32) *(u32x2*)dst = o; }
        }
        {
            const int pos = lat ? (r & 2047) : ((r - TL) & 255); const int n = lat ? 2048 : 256;
            const bool hp = pos > 0, hn = pos < n - 1;
            u32x2 x0[3], x1[3], x2[3];
#pragma unroll
            for (int j = 0; j < 3; ++j) { const bf16_t* xp = pr + C_CQKV + j * 256 + 4 * lane;
                x1[j] = *(const u32x2*)xp; x0[j] = hp ? *(const u32x2*)(xp - NPAD) : (u32x2){0u, 0u}; x2[j] = hn ? *(const u32x2*)(xp + NPAD) : (u32x2){0u, 0u}; }
#pragma unroll
            for (int j = 0; j < 3; ++j) { const int ch = j * 256 + 4 * lane;
                const f32x4 w0 = cwr[j][0], w1 = cwr[j][1], w2 = cwr[j][2];
                const float a0[4] = {bflo(x0[j].x), bfhi(x0[j].x), bflo(x0[j].y), bfhi(x0[j].y)}, a1[4] = {bflo(x1[j].x), bfhi(x1[j].x), bflo(x1[j].y), bfhi(x1[j].y)}, a2[4] = {bflo(x2[j].x), bfhi(x2[j].x), bflo(x2[j].y), bfhi(x2[j].y)};
                float v[4];
#pragma unroll
                for (int e = 0; e < 4; ++e) v[e] = silu_f(a0[e] * w0[e] + a1[e] * w1[e] + a2[e] * w2[e]);
                if (j < 2) { float ss = (v[0] * v[0] + v[1] * v[1]) + (v[2] * v[2] + v[3] * v[3]);
                    ss = row16_sum(ss);
                    const float rn = rsqrtf(ss + EPS) * (j == 0 ? 0.125f : 1.f);
#pragma unroll
                    for (int e = 0; e < 4; ++e) v[e] *= rn; }
                u32x2 o; o.x = pk2(v[0], v[1]); o.y = pk2(v[2], v[3]);
                *(u32x2*)((dry ? (bf16_t*)(p.ws + WS_CL) : CQ) + (size_t)r * 768 + ch) = o; }
            if (lane < 8) { const int dir = lane >> 2, h = lane & 3;
                const float be = sigm_f(bf2f(pr[C_CBETA + lane]));
                const float a = bf2f(pr[C_CA + lane]);
                const float la = -expf(p.in[I_CALOG][l * 8 + dir * 4 + h]) * softplus_f(a + p.in[I_CDTB][l * 8 + dir * 4 + h]);
                float* GBw = dry ? (float*)(p.ws + WS_DL) : GB; GBw[(size_t)r * 16 + lane] = be; GBw[(size_t)r * 16 + 8 + lane] = la; }
        }
        {
            const float lrv = bf2f(pr[C_DLR + (lane & 31)]);
#pragma unroll
            for (int q4 = 0; q4 < 4; ++q4) { const int zz = q4 >> 1;
                float z = gbr[q4];
#pragma unroll
                for (int rr = 0; rr < 16; ++rr) z += __int_as_float(__builtin_amdgcn_readlane(__float_as_int(lrv), zz * 16 + rr)) * gwr[q4][rr];
                const float ls = fminf(z, 0.f) - __logf(1.f + __expf(-fabsf(z)));
                (dry ? (_Float16*)(p.ws + WS_CL) + (size_t)TT * 768 : LA)[(size_t)r * 256 + q4 * 64 + lane] = (_Float16)(ls * (1.f / 16.f)); }
        }
    }
}

typedef float f32x16 __attribute__((ext_vector_type(16)));
constexpr int ATT_KP = 72, ATT_VP = 96, ATT_VOFF = 64 * ATT_KP * 2, ATT_BUF = ATT_VOFF + 64 * ATT_VP * 2;
typedef short v4i16_t __attribute__((ext_vector_type(4)));
__device__ __forceinline__ u32x2 vtr_read(const LAS unsigned char* a) { return __builtin_bit_cast(u32x2, __builtin_amdgcn_ds_read_tr16_b64_v4i16((LAS v4i16_t*)a)); }
__device__ __forceinline__ int vtr_base(int lane) { return ((4 * (lane >> 5) + ((lane >> 2) & 3)) * ATT_VP + 16 * ((lane >> 4) & 1) + 4 * (lane & 3)) * 2; }
template <bool QS>
__device__ __forceinline__ void attn_mfma_unit(const Params& p, LAS unsigned char* lds, int qrow_w, int qcol_w, int ocol_w, int kcol, int vcol,
                                               int kb0, int kn0, int kb1, int kn1, int wv) {
    const int tid = opq(TIDX(wv)), lane = tid & 63, r = lane & 31, h = lane >> 5;
    const bf16_t* P = (const bf16_t*)(p.ws + WS_P); bf16_t* O = (bf16_t*)(p.ws + WS_O);
    constexpr float C = 0.125f * 1.4426950408889634f;
    bf16x8 qf[4];
    { const bf16_t* qp = P + (size_t)(qrow_w + r) * NPAD + qcol_w + 8 * h;
#pragma unroll
        for (int s = 0; s < 4; ++s) qf[s] = *(const bf16x8*)(qp + 16 * s); }
    f32x16 ot0, ot1;
#pragma unroll
    for (int i = 0; i < 16; ++i) { ot0[i] = 0.f; ot1[i] = 0.f; }
    float m = QS ? 0.f : -1e30f, lsum = 0.f;
    f32x16 negm;
#pragma unroll
    for (int i = 0; i < 16; ++i) negm[i] = 0.f;
    const int ntile = (kn0 + kn1) >> 6, nt0 = kn0 >> 6;
    const int lkey = tid >> 3, lc8 = tid & 7;
    u32x4 kreg, vreg;
    { const bf16_t* src = P + (size_t)((0 < nt0 ? kb0 : kb1) + lkey) * NPAD; kreg = *(const u32x4*)(src + kcol + lc8 * 8); vreg = *(const u32x4*)(src + vcol + lc8 * 8); }
    __syncthreads();
    for (int t = 0; t < ntile; ++t) {
        LAS unsigned char* buf = lds + (t & 1) * ATT_BUF;
        {
            *(LAS u32x4*)(buf + (lkey * ATT_KP + lc8 * 8) * 2) = kreg;
            *(LAS u32x4*)(buf + ATT_VOFF + (lkey * ATT_VP + lc8 * 8) * 2) = vreg;
        }
        if (t + 1 < ntile) { const int tn = t + 1; const int row = (tn < nt0 ? kb0 + tn * 64 : kb1 + (tn - nt0) * 64) + lkey;
            const bf16_t* src = P + (size_t)row * NPAD; kreg = *(const u32x4*)(src + kcol + lc8 * 8); vreg = *(const u32x4*)(src + vcol + lc8 * 8); }
        __syncthreads();
        f32x16 x0, x1;
        const LAS unsigned char* kp0 = buf + (r * ATT_KP + 8 * h) * 2;
        const LAS unsigned char* vp0 = buf + ATT_VOFF + vtr_base(lane);
        {
            bf16x8 ka[4], kb[4];
#pragma unroll
            for (int s = 0; s < 4; ++s) { ka[s] = *(const LAS bf16x8*)(kp0 + s * 32); kb[s] = *(const LAS bf16x8*)(kp0 + 32 * ATT_KP * 2 + s * 32); }
            __builtin_amdgcn_sched_barrier(0);
            x0 = __builtin_amdgcn_mfma_f32_32x32x16_bf16(ka[0], qf[0], negm, 0, 0, 0); x1 = __builtin_amdgcn_mfma_f32_32x32x16_bf16(kb[0], qf[0], negm, 0, 0, 0);
#pragma unroll
            for (int s = 1; s < 4; ++s) { x0 = __builtin_amdgcn_mfma_f32_32x32x16_bf16(ka[s], qf[s], x0, 0, 0, 0); x1 = __builtin_amdgcn_mfma_f32_32x32x16_bf16(kb[s], qf[s], x1, 0, 0, 0); }
        }
        u32x2 vfa[4][2], vfb[4][2];
#pragma unroll
        for (int ks = 0; ks < 4; ++ks) { const int ko = 16 * ks * ATT_VP * 2;
            vfa[ks][0] = vtr_read(vp0 + ko); vfa[ks][1] = vtr_read(vp0 + ko + 8 * ATT_VP * 2);
            vfb[ks][0] = vtr_read(vp0 + ko + 64); vfb[ks][1] = vtr_read(vp0 + ko + 8 * ATT_VP * 2 + 64); }
        __builtin_amdgcn_sched_barrier(0);
        float mx = x0[0];
#pragma unroll
        for (int i = 1; i < 16; ++i) mx = fmaxf(mx, x0[i]);
#pragma unroll
        for (int i = 0; i < 16; ++i) mx = fmaxf(mx, x1[i]);
        { auto rr = __builtin_amdgcn_permlane32_swap(__float_as_uint(mx), __float_as_uint(mx), false, false); mx = fmaxf(__uint_as_float(rr[0]), __uint_as_float(rr[1])); }
        float ps = 0.f;
        if (QS) {
            const bool grow = (t == 0) || (mx > 8.f);
            if (__any(grow)) {
                const float d = grow ? mx : 0.f; m += d;
                const float corr = (t == 0) ? 1.f : __builtin_amdgcn_exp2f(-d); lsum *= corr;
#pragma unroll
                for (int i = 0; i < 16; ++i) { ot0[i] *= corr; ot1[i] *= corr; x0[i] -= d; x1[i] -= d; negm[i] = -m; } }
#pragma unroll
            for (int i = 0; i < 16; ++i) { x0[i] = __builtin_amdgcn_exp2f(x0[i]); x1[i] = __builtin_amdgcn_exp2f(x1[i]); ps += x0[i] + x1[i]; }
        } else {
            const float mn = fmaxf(m, mx * C);
            if (__any(mn > m)) {
                const float corr = __builtin_amdgcn_exp2f(m - mn); m = mn; lsum *= corr;
#pragma unroll
                for (int i = 0; i < 16; ++i) { ot0[i] *= corr; ot1[i] *= corr; } }
#pragma unroll
            for (int i = 0; i < 16; ++i) { x0[i] = __builtin_amdgcn_exp2f(fmaf(x0[i], C, -m)); x1[i] = __builtin_amdgcn_exp2f(fmaf(x1[i], C, -m)); ps += x0[i] + x1[i]; }
        }
        lsum += ps;
#pragma unroll
        for (int kt = 0; kt < 2; ++kt) {
#pragma unroll
            for (int s = 0; s < 2; ++s) {
                const f32x16& x = kt ? x1 : x0;
                u32x4 pw; pw.x = pg8::cvt_pk_bf16(x[8 * s], x[8 * s + 1]); pw.y = pg8::cvt_pk_bf16(x[8 * s + 2], x[8 * s + 3]);
                pw.z = pg8::cvt_pk_bf16(x[8 * s + 4], x[8 * s + 5]); pw.w = pg8::cvt_pk_bf16(x[8 * s + 6], x[8 * s + 7]);
                const bf16x8 pb = __builtin_bit_cast(bf16x8, pw);
                const int ks = kt * 2 + s;
                const u32x4 va = (u32x4){vfa[ks][0].x, vfa[ks][0].y, vfa[ks][1].x, vfa[ks][1].y}, vb = (u32x4){vfb[ks][0].x, vfb[ks][0].y, vfb[ks][1].x, vfb[ks][1].y};
                ot0 = __builtin_amdgcn_mfma_f32_32x32x16_bf16(__builtin_bit_cast(bf16x8, va), pb, ot0, 0, 0, 0);
                ot1 = __builtin_amdgcn_mfma_f32_32x32x16_bf16(__builtin_bit_cast(bf16x8, vb), pb, ot1, 0, 0, 0);
            }
        }
    }
    { auto rr = __builtin_amdgcn_permlane32_swap(__float_as_uint(lsum), __float_as_uint(lsum), false, false); lsum = __uint_as_float(rr[0]) + __uint_as_float(rr[1]); }
    const float inv = 1.f / lsum;
    bf16_t* op = O + (size_t)(qrow_w + r) * D + ocol_w + 4 * h;
#pragma unroll
    for (int i = 0; i < 4; ++i) {
        u32x2 w0, w1;
        w0.x = pg8::cvt_pk_bf16(ot0[4 * i] * inv, ot0[4 * i + 1] * inv); w0.y = pg8::cvt_pk_bf16(ot0[4 * i + 2] * inv, ot0[4 * i + 3] * inv);
        w1.x = pg8::cvt_pk_bf16(ot1[4 * i] * inv, ot1[4 * i + 1] * inv); w1.y = pg8::cvt_pk_bf16(ot1[4 * i + 2] * inv, ot1[4 * i + 3] * inv);
        *(u32x2*)(op + 8 * i) = w0; *(u32x2*)(op + 32 + 8 * i) = w1;
    }
}
__device__ __forceinline__ void attn_na_unit(const Params& p, LAS unsigned char* lds, int l, int b, int hd, int rg, int wv) {
    const int tid = opq(TIDX(wv)), lane = tid & 63, r = lane & 31, h = lane >> 5, wave = tid >> 6;
    const bf16_t* P = (const bf16_t*)(p.ws + WS_P); bf16_t* O = (bf16_t*)(p.ws + WS_O);
    constexpr float C = 0.125f * 1.4426950408889634f;
    const int gr = rg * 4 + (wave >> 1), qc = (wave & 1) * 32 + r, cs = min(max(qc - 8, 0), 48), rs = min(max(gr - 4, 0), 24);
    const int u0 = min(max(rg * 4 - 4, 0), 24), u1 = min(max(rg * 4 - 1, 0), 24) + 8, nloc = u1 - u0, ntile = nloc + 4;
    const int qrow = b * 2048 + gr * 64 + qc;
    LAS float* tb = (LAS float*)(lds + 2 * ATT_BUF);
    __syncthreads();
    { const float* rpb = p.in[I_RPB] + (size_t)(l * 4 + hd) * 15 * 31;
        if (tid < 480) tb[tid] = (tid & 31) < 31 ? rpb[(tid >> 5) * 31 + (tid & 31)] * 1.4426950408889634f : 0.f; }
    bf16x8 qf[4];
    { const bf16_t* qp = P + (size_t)qrow * NPAD + C_BQ + hd * 64 + 8 * h;
#pragma unroll
        for (int s = 0; s < 4; ++s) qf[s] = *(const bf16x8*)(qp + 16 * s); }
    f32x16 ot0, ot1;
#pragma unroll
    for (int i = 0; i < 16; ++i) { ot0[i] = 0.f; ot1[i] = 0.f; }
    float m = -1e30f, lsum = 0.f;
    const int lkey = tid >> 3, lc8 = tid & 7;
    const int kcol = C_BK + hd * 64, vcol = C_BV + hd * 64;
    u32x4 kreg, vreg;
    { const bf16_t* src = P + (size_t)(b * 2048 + u0 * 64 + lkey) * NPAD; kreg = *(const u32x4*)(src + kcol + lc8 * 8); vreg = *(const u32x4*)(src + vcol + lc8 * 8); }
    for (int t = 0; t < ntile; ++t) {
        LAS unsigned char* buf = lds + (t & 1) * ATT_BUF;
        {
            *(LAS u32x4*)(buf + (lkey * ATT_KP + lc8 * 8) * 2) = kreg;
            *(LAS u32x4*)(buf + ATT_VOFF + (lkey * ATT_VP + lc8 * 8) * 2) = vreg;
        }
        if (t + 1 < ntile) { const int tn = t + 1; const int row = (tn < nloc ? b * 2048 + (u0 + tn) * 64 : TL + b * 256 + (tn - nloc) * 64) + lkey;
            const bf16_t* src = P + (size_t)row * NPAD; kreg = *(const u32x4*)(src + kcol + lc8 * 8); vreg = *(const u32x4*)(src + vcol + lc8 * 8); }
        __syncthreads();
        const bool loc = t < nloc; const int kr = u0 + t;
        if (!loc || (kr >= rs && kr < rs + 8)) {
            f32x16 x0, x1;
#pragma unroll
            for (int i = 0; i < 16; ++i) { x0[i] = 0.f; x1[i] = 0.f; }
            const LAS unsigned char* kp0 = buf + (r * ATT_KP + 8 * h) * 2;
            const LAS unsigned char* vp0 = buf + ATT_VOFF + vtr_base(lane);
            {
                bf16x8 ka[4], kb[4];
#pragma unroll
                for (int s = 0; s < 4; ++s) { ka[s] = *(const LAS bf16x8*)(kp0 + s * 32); kb[s] = *(const LAS bf16x8*)(kp0 + 32 * ATT_KP * 2 + s * 32); }
                __builtin_amdgcn_sched_barrier(0);
#pragma unroll
                for (int s = 0; s < 4; ++s) { x0 = __builtin_amdgcn_mfma_f32_32x32x16_bf16(ka[s], qf[s], x0, 0, 0, 0); x1 = __builtin_amdgcn_mfma_f32_32x32x16_bf16(kb[s], qf[s], x1, 0, 0, 0); }
            }
            u32x2 vfa[4][2], vfb[4][2];
#pragma unroll
            for (int ks = 0; ks < 4; ++ks) { const int ko = 16 * ks * ATT_VP * 2;
                vfa[ks][0] = vtr_read(vp0 + ko); vfa[ks][1] = vtr_read(vp0 + ko + 8 * ATT_VP * 2);
                vfb[ks][0] = vtr_read(vp0 + ko + 64); vfb[ks][1] = vtr_read(vp0 + ko + 8 * ATT_VP * 2 + 64); }
            __builtin_amdgcn_sched_barrier(0);
            if (loc) {
                const LAS float* trow = tb + (kr - gr + 7) * 32;
#pragma unroll
                for (int i = 0; i < 16; ++i) {
                    const int kc0 = (i & 3) + 8 * (i >> 2) + 4 * h, kc1 = kc0 + 32;
                    const int d0 = kc0 - cs, d1 = kc1 - cs;
                    const float b0 = trow[min(max(kc0 - qc + 15, 0), 30)], b1 = trow[min(max(kc1 - qc + 15, 0), 30)];
                    x0[i] = (d0 >= 0 && d0 < 16) ? fmaf(x0[i], C, b0) : -1e30f;
                    x1[i] = (d1 >= 0 && d1 < 16) ? fmaf(x1[i], C, b1) : -1e30f;
                }
            } else {
#pragma unroll
                for (int i = 0; i < 16; ++i) { x0[i] *= C; x1[i] *= C; }
            }
            float mx = x0[0];
#pragma unroll
            for (int i = 1; i < 16; ++i) mx = fmaxf(mx, x0[i]);
#pragma unroll
            for (int i = 0; i < 16; ++i) mx = fmaxf(mx, x1[i]);
            { auto rr = __builtin_amdgcn_permlane32_swap(__float_as_uint(mx), __float_as_uint(mx), false, false); mx = fmaxf(__uint_as_float(rr[0]), __uint_as_float(rr[1])); }
            const bool grow = (m < -1e29f) || (mx > m + 8.f);
            if (__any(grow)) { const float mn = grow ? mx : m; const float corr = __builtin_amdgcn_exp2f(m - mn); m = mn; lsum *= corr;
#pragma unroll
                for (int i = 0; i < 16; ++i) { ot0[i] *= corr; ot1[i] *= corr; } }
            float ps = 0.f;
#pragma unroll
            for (int i = 0; i < 16; ++i) { x0[i] = __builtin_amdgcn_exp2f(x0[i] - m); x1[i] = __builtin_amdgcn_exp2f(x1[i] - m); ps += x0[i] + x1[i]; }
            lsum += ps;
#pragma unroll
            for (int kt = 0; kt < 2; ++kt) {
#pragma unroll
                for (int s = 0; s < 2; ++s) {
                    const f32x16& x = kt ? x1 : x0;
                    u32x4 pw; pw.x = pg8::cvt_pk_bf16(x[8 * s], x[8 * s + 1]); pw.y = pg8::cvt_pk_bf16(x[8 * s + 2], x[8 * s + 3]);
                    pw.z = pg8::cvt_pk_bf16(x[8 * s + 4], x[8 * s + 5]); pw.w = pg8::cvt_pk_bf16(x[8 * s + 6], x[8 * s + 7]);
                    const bf16x8 pb = __builtin_bit_cast(bf16x8, pw);
                    const int ks = kt * 2 + s;
                    const u32x4 va = (u32x4){vfa[ks][0].x, vfa[ks][0].y, vfa[ks][1].x, vfa[ks][1].y}, vb = (u32x4){vfb[ks][0].x, vfb[ks][0].y, vfb[ks][1].x, vfb[ks][1].y};
                    ot0 = __builtin_amdgcn_mfma_f32_32x32x16_bf16(__builtin_bit_cast(bf16x8, va), pb, ot0, 0, 0, 0);
                    ot1 = __builtin_amdgcn_mfma_f32_32x32x16_bf16(__builtin_bit_cast(bf16x8, vb), pb, ot1, 0, 0, 0);
                }
            }
        }
    }
    { auto rr = __builtin_amdgcn_permlane32_swap(__float_as_uint(lsum), __float_as_uint(lsum), false, false); lsum = __uint_as_float(rr[0]) + __uint_as_float(rr[1]); }
    const float inv = 1.f / lsum;
    bf16_t* op = O + (size_t)qrow * D + 256 + hd * 64 + 4 * h;
#pragma unroll
    for (int i = 0; i < 4; ++i) {
        u32x2 w0, w1;
        w0.x = pg8::cvt_pk_bf16(ot0[4 * i] * inv, ot0[4 * i + 1] * inv); w0.y = pg8::cvt_pk_bf16(ot0[4 * i + 2] * inv, ot0[4 * i + 3] * inv);
        w1.x = pg8::cvt_pk_bf16(ot1[4 * i] * inv, ot1[4 * i + 1] * inv); w1.y = pg8::cvt_pk_bf16(ot1[4 * i + 2] * inv, ot1[4 * i + 3] * inv);
        *(u32x2*)(op + 8 * i) = w0; *(u32x2*)(op + 32 + 8 * i) = w1;
    }
}
__device__ __forceinline__ void chunk_rows(int b, int dir, int c, int& rb, int& n, int& cc) { const int seg = c >= 4; cc = seg ? c - 4 : c; n = seg ? 2048 : 256; rb = seg ? b * 2048 : TL + b * 256; }
__device__ __forceinline__ int opqd(int v, float dep) { asm volatile("" : "+v"(v) : "v"(dep)); return v; }
__device__ __forceinline__ int crow(int reg, int hh) { return (reg & 3) + 8 * (reg >> 2) + 4 * hh; }
#define WY_FRAG(X, s, f0, f1) do { \
    const unsigned pa0_ = pg8::cvt_pk_bf16(X[16 * (s) + 0], X[16 * (s) + 1]), pa1_ = pg8::cvt_pk_bf16(X[16 * (s) + 2], X[16 * (s) + 3]), pa2_ = pg8::cvt_pk_bf16(X[16 * (s) + 8], X[16 * (s) + 9]), pa3_ = pg8::cvt_pk_bf16(X[16 * (s) + 10], X[16 * (s) + 11]); \
    const unsigned pb0_ = pg8::cvt_pk_bf16(X[16 * (s) + 4], X[16 * (s) + 5]), pb1_ = pg8::cvt_pk_bf16(X[16 * (s) + 6], X[16 * (s) + 7]), pb2_ = pg8::cvt_pk_bf16(X[16 * (s) + 12], X[16 * (s) + 13]), pb3_ = pg8::cvt_pk_bf16(X[16 * (s) + 14], X[16 * (s) + 15]); \
    const auto r0_ = __builtin_amdgcn_permlane32_swap(pa0_, pb0_, false, false); const auto r1_ = __builtin_amdgcn_permlane32_swap(pa1_, pb1_, false, false); \
    const auto r2_ = __builtin_amdgcn_permlane32_swap(pa2_, pb2_, false, false); const auto r3_ = __builtin_amdgcn_permlane32_swap(pa3_, pb3_, false, false); \
    f0 = __builtin_bit_cast(bf16x8, (u32x4){r0_[0], r1_[0], r2_[0], r3_[0]}); f1 = __builtin_bit_cast(bf16x8, (u32x4){r0_[1], r1_[1], r2_[1], r3_[1]}); } while (0)
__device__ __forceinline__ bf16x8 acc_frag(const f32x16& x, int s) {
    u32x4 w; w.x = pg8::cvt_pk_bf16(x[8 * s], x[8 * s + 1]); w.y = pg8::cvt_pk_bf16(x[8 * s + 2], x[8 * s + 3]); w.z = pg8::cvt_pk_bf16(x[8 * s + 4], x[8 * s + 5]); w.w = pg8::cvt_pk_bf16(x[8 * s + 6], x[8 * s + 7]);
    return __builtin_bit_cast(bf16x8, w); }
constexpr int WY_LDS = 17408;
__device__ __forceinline__ void wyC_pass1(const Params& p, int task, LAS unsigned char* wl, int lane_) {
    const int lane = opq(lane_);
    const int c = task % 36, chain = task / 36, dir = chain & 1, h = (chain >> 1) & 3, b = chain >> 3, r = lane & 31, hh = lane >> 5;
    int rb, n, cc; chunk_rows(b, dir, c, rb, n, cc);
    const bf16_t* CQ = (const bf16_t*)(p.ws + WS_X + X_CQ); const float* GB = (const float*)(p.ws + WS_GB);
    float* CM = (float*)(p.ws + WS_CM) + (size_t)task * 4096; float* CL = (float*)(p.ws + WS_CL) + (size_t)task * 4096;
    bf16_t* QE = (bf16_t*)(p.ws + WS_H + 36 * MiB) + (size_t)task * 4096;
    bf16_t* Od = (bf16_t*)(p.ws + WS_X + X_OC) + (size_t)dir * TT * 256;
    LAS float* Ls = (LAS float*)wl; LAS float* tbe = Ls + 4096; LAS float* tg = tbe + 64; LAS float* teg = tg + 64; LAS float* tla = teg + 64;
#define WY_ROW(i_) ((size_t)(rb + (dir ? n - 1 - (cc * 64 + (i_)) : cc * 64 + (i_))))
    const size_t myrow = WY_ROW(lane);
    const float be_l = GB[myrow * 16 + dir * 4 + h], la_l = GB[myrow * 16 + 8 + dir * 4 + h];
    bf16x8 kf[2][4];
#pragma unroll
    for (int t = 0; t < 2; ++t) { const bf16_t* kp = CQ + WY_ROW(t * 32 + r) * 768 + 256 + h * 64 + 8 * hh;
#pragma unroll
        for (int s = 0; s < 4; ++s) kf[t][s] = *(const bf16x8*)(kp + 16 * s); }
    tla[lane] = la_l; tbe[lane] = be_l;
    asm volatile("s_waitcnt lgkmcnt(0)" ::: "memory"); __builtin_amdgcn_wave_barrier();
    float g_l = 0.f, gtot = 0.f;
#pragma unroll
    for (int t8 = 0; t8 < 2; ++t8) { f32x4 xq[8];
#pragma unroll
        for (int t4 = 0; t4 < 8; ++t4) xq[t4] = *(const LAS f32x4*)(tla + 32 * t8 + 4 * t4);
        __builtin_amdgcn_sched_barrier(0);
#pragma unroll
        for (int t4 = 0; t4 < 8; ++t4)
#pragma unroll
            for (int e = 0; e < 4; ++e) { g_l += (32 * t8 + 4 * t4 + e <= lane) ? xq[t4][e] : 0.f; gtot += xq[t4][e]; }
        __builtin_amdgcn_sched_barrier(0); }
    tg[lane] = g_l; teg[lane] = __expf(g_l);
    asm volatile("s_waitcnt lgkmcnt(0)" ::: "memory"); __builtin_amdgcn_wave_barrier();
    const float egtot = __expf(gtot);
    float l21t[16];
    {
        {
            f32x16 a;
#pragma unroll
            for (int i = 0; i < 16; ++i) a[i] = 0.f;
#pragma unroll
            for (int s = 0; s < 4; ++s) a = __builtin_amdgcn_mfma_f32_32x32x16_bf16(kf[0][s], kf[1][s], a, 0, 0, 0);
            const float gi = tg[32 + r], bi = tbe[32 + r];
#pragma unroll
            for (int q = 0; q < 4; ++q) { const f32x4 gj = *(const LAS f32x4*)(tg + 8 * q + 4 * hh);
#pragma unroll
                for (int e = 0; e < 4; ++e) l21t[4 * q + e] = bi * a[4 * q + e] * __expf(gi - gj[e]); }
        }
#pragma unroll
        for (int tile = 0; tile < 2; ++tile) { const int it = tile, jt = tile;
            f32x16 a;
#pragma unroll
            for (int i = 0; i < 16; ++i) a[i] = 0.f;
#pragma unroll
            for (int s = 0; s < 4; ++s) a = __builtin_amdgcn_mfma_f32_32x32x16_bf16(kf[it][s], kf[jt][s], a, 0, 0, 0);
            const int j = jt * 32 + r; const float gj = tg[j];
#pragma unroll
            for (int q = 0; q < 4; ++q) { const f32x4 gi = *(const LAS f32x4*)(tg + it * 32 + 8 * q + 4 * hh), bi = *(const LAS f32x4*)(tbe + it * 32 + 8 * q + 4 * hh);
#pragma unroll
                for (int e = 0; e < 4; ++e) { const int i = it * 32 + 8 * q + 4 * hh + e;
                    Ls[i * 64 + j] = (j < i) ? bi[e] * a[4 * q + e] * __expf(gi[e] - gj) : 0.f; } }
        }
    }
    asm volatile("s_waitcnt lgkmcnt(0)" ::: "memory"); __builtin_amdgcn_wave_barrier();
    bf16x8 Wp[4][2], Up[4][2]; float dep = egtot;
#pragma unroll 1
    for (int which = 0; which < 2; ++which) {
        float x[64]; const int lane = opqd(lane_, dep);
        const long rstep = dir ? -768 : 768;
        const bf16_t* rp = CQ + WY_ROW(0) * 768 + 256 + which * 256 + h * 64;
        const float cw = tbe[lane] * (which ? 1.f : teg[lane]);
        { bf16_t xraw[64];
#pragma unroll
          for (int i = 0; i < 64; ++i) { xraw[i] = rp[lane]; rp += rstep; }
          __builtin_amdgcn_sched_barrier(0);
#pragma unroll
          for (int i = 0; i < 64; ++i) x[i] = __int_as_float(__builtin_amdgcn_readlane(__float_as_int(cw), i)) * bf2f(xraw[i]); }
#pragma unroll
        for (int i = 1; i < 32; ++i) { f32x4 lv[8];
#pragma unroll
            for (int j4 = 0; j4 < (i + 3) / 4; ++j4) lv[j4] = *(const LAS f32x4*)(Ls + i * 64 + 4 * j4);
            __builtin_amdgcn_sched_barrier(0);
#pragma unroll
            for (int j4 = 0; j4 < (i + 3) / 4; ++j4)
#pragma unroll
                for (int e = 0; e < 4; ++e) if (4 * j4 + e < i) x[i] -= lv[j4][e] * x[4 * j4 + e];
            __builtin_amdgcn_sched_barrier(0); }
        {
            f32x16 d0, d1;
#pragma unroll
            for (int i = 0; i < 16; ++i) { d0[i] = 0.f; d1[i] = 0.f; }
#pragma unroll
            for (int s = 0; s < 16; ++s) { const int j0 = (s & 3) + 8 * (s >> 2);
                const auto bb = __builtin_amdgcn_permlane32_swap(__float_as_uint(x[j0]), __float_as_uint(x[j0 + 4]), false, false);
                d0 = __builtin_amdgcn_mfma_f32_32x32x2f32(l21t[s], __uint_as_float(bb[0]), d0, 0, 0, 0);
                d1 = __builtin_amdgcn_mfma_f32_32x32x2f32(l21t[s], __uint_as_float(bb[1]), d1, 0, 0, 0); }
#pragma unroll
            for (int t = 0; t < 16; ++t) { const int i0 = 32 + (t & 3) + 8 * (t >> 2);
                const auto dd = __builtin_amdgcn_permlane32_swap(__float_as_uint(d0[t]), __float_as_uint(d1[t]), false, false);
                x[i0] -= __uint_as_float(dd[0]); x[i0 + 4] -= __uint_as_float(dd[1]); }
        }
#pragma unroll
        for (int i = 33; i < 64; ++i) { f32x4 lv[8];
#pragma unroll
            for (int j4 = 8; j4 < (i + 3) / 4; ++j4) lv[j4 - 8] = *(const LAS f32x4*)(Ls + i * 64 + 4 * j4);
            __builtin_amdgcn_sched_barrier(0);
#pragma unroll
            for (int j4 = 8; j4 < (i + 3) / 4; ++j4)
#pragma unroll
                for (int e = 0; e < 4; ++e) if (4 * j4 + e < i) x[i] -= lv[j4 - 8][e] * x[4 * j4 + e];
            __builtin_amdgcn_sched_barrier(0); }
        dep = x[63];
        if (which == 0) {
#pragma unroll
            for (int s = 0; s < 4; ++s) WY_FRAG(x, s, Wp[s][0], Wp[s][1]); }
        else {
#pragma unroll
            for (int s = 0; s < 4; ++s) WY_FRAG(x, s, Up[s][0], Up[s][1]); }
    }
    __builtin_amdgcn_sched_barrier(0);
    {
        const int lane = opqd(lane_, dep), r = lane & 31, hh = lane >> 5;
        bf16x8 Kp[4][2];
        { const long rstep = dir ? -768 : 768; const bf16_t* rp = CQ + WY_ROW(0) * 768 + 256 + h * 64;
            bf16_t kraw[64];
#pragma unroll
            for (int i = 0; i < 64; ++i) { kraw[i] = rp[lane]; rp += rstep; }
            __builtin_amdgcn_sched_barrier(0);
#pragma unroll
            for (int s = 0; s < 4; ++s) { float kg[16];
#pragma unroll
                for (int ii = 0; ii < 16; ++ii) kg[ii] = bf2f(kraw[16 * s + ii]) * __expf(gtot - tg[16 * s + ii]);
                WY_FRAG(kg, 0, Kp[s][0], Kp[s][1]);
                __builtin_amdgcn_sched_barrier(0); } }
#pragma unroll
        for (int which = 0; which < 2; ++which)
#pragma unroll
            for (int rt = 0; rt < 2; ++rt)
#pragma unroll
                for (int ct = 0; ct < 2; ++ct) { f32x16 a;
#pragma unroll
                    for (int i = 0; i < 16; ++i) a[i] = 0.f;
#pragma unroll
                    for (int s = 0; s < 4; ++s) a = __builtin_amdgcn_mfma_f32_32x32x16_bf16(Kp[s][rt], which ? Up[s][ct] : Wp[s][ct], a, 0, 0, 0);
                    char* dst = (char*)(which ? CL : CM); const unsigned o0 = (unsigned)(((rt * 32 + 4 * hh) * 64 + ct * 32 + r) * 4);
#pragma unroll
                    for (int i = 0; i < 16; ++i) { const int dp = rt * 32 + crow(i, hh), dc = ct * 32 + r;
                        *(float*)(dst + (o0 + (unsigned)((((i & 3) + 8 * (i >> 2)) * 64) * 4))) = which ? a[i] : ((dp == dc ? egtot : 0.f) - a[i]); }
                    dep = a[15]; }
    }
    {
        const int lane = opqd(lane_, dep), r = lane & 31, hh = lane >> 5;
        f32x16 qk[3];
        u32x2 qwv[2][2][4];
        {
            bf16x8 kfG[2][4], qfG[2][4];
#pragma unroll
            for (int t2 = 0; t2 < 2; ++t2) { const bf16_t* kp = CQ + WY_ROW(t2 * 32 + r) * 768 + 256 + h * 64 + 8 * hh; const bf16_t* qp = CQ + WY_ROW(t2 * 32 + r) * 768 + h * 64 + 8 * hh;
#pragma unroll
                for (int s = 0; s < 4; ++s) { kfG[t2][s] = *(const bf16x8*)(kp + 16 * s); qfG[t2][s] = *(const bf16x8*)(qp + 16 * s); } }
            __builtin_amdgcn_sched_barrier(0);
#pragma unroll
            for (int it = 0; it < 2; ++it)
#pragma unroll
                for (int s = 0; s < 4; ++s) { const u32x4 w_ = __builtin_bit_cast(u32x4, qfG[it][s]);
                    const auto s0_ = __builtin_amdgcn_permlane32_swap(w_.x, w_.z, false, false); const auto s1_ = __builtin_amdgcn_permlane32_swap(w_.y, w_.w, false, false);
                    qwv[s >> 1][it][2 * (s & 1)] = (u32x2){s0_[0], s1_[0]}; qwv[s >> 1][it][2 * (s & 1) + 1] = (u32x2){s0_[1], s1_[1]}; }
#pragma unroll
            for (int tile = 0; tile < 3; ++tile) { const int jt = tile == 2, it = tile >= 1;
                f32x16 a;
#pragma unroll
                for (int i = 0; i < 16; ++i) a[i] = 0.f;
#pragma unroll
                for (int s = 0; s < 4; ++s) a = __builtin_amdgcn_mfma_f32_32x32x16_bf16(kfG[jt][s], qfG[it][s], a, 0, 0, 0);
                const int i = it * 32 + r; const float gi = tg[i];
#pragma unroll
                for (int q = 0; q < 4; ++q) { const f32x4 gj = *(const LAS f32x4*)(tg + jt * 32 + 8 * q + 4 * hh);
#pragma unroll
                    for (int e = 0; e < 4; ++e) { const int j = jt * 32 + 8 * q + 4 * hh + e; a[4 * q + e] = (j <= i) ? a[4 * q + e] * __expf(gi - gj[e]) : 0.f; } }
                qk[tile] = a; } }
        const int lane3 = opqd(lane_, qk[2][15]), r3 = lane3 & 31, hh3 = lane3 >> 5;
#pragma unroll
        for (int which = 0; which < 2; ++which)
#pragma unroll
            for (int dt = 0; dt < 2; ++dt)
#pragma unroll
                for (int it = 0; it < 2; ++it) { f32x16 a;
#pragma unroll
                    for (int i = 0; i < 16; ++i) a[i] = 0.f;
#pragma unroll
                    for (int jt = 0; jt <= it; ++jt) { const f32x16& x = (jt == 0) ? (it == 0 ? qk[0] : qk[1]) : qk[2];
#pragma unroll
                        for (int s2 = 0; s2 < 2; ++s2) a = __builtin_amdgcn_mfma_f32_32x32x16_bf16(which ? Up[2 * jt + s2][dt] : Wp[2 * jt + s2][dt], acc_frag(x, s2), a, 0, 0, 0); }
                    const int i = it * 32 + r3; const size_t ri = WY_ROW(i);
                    if (which == 0) { const float eg = teg[i];
#pragma unroll
                        for (int q = 0; q < 4; ++q) { const int d0 = dt * 32 + 8 * q + 4 * hh3; const u32x2 qw = qwv[dt][it][q];
                            u32x2 w; w.x = pg8::cvt_pk_bf16(bflo(qw.x) * eg - a[4 * q], bfhi(qw.x) * eg - a[4 * q + 1]); w.y = pg8::cvt_pk_bf16(bflo(qw.y) * eg - a[4 * q + 2], bfhi(qw.y) * eg - a[4 * q + 3]);
                            *(u32x2*)(QE + i * 64 + d0) = w; } }
                    else {
#pragma unroll
                        for (int q = 0; q < 4; ++q) { const int e0 = dt * 32 + 8 * q + 4 * hh3;
                            u32x2 w; w.x = pk2(a[4 * q], a[4 * q + 1]); w.y = pk2(a[4 * q + 2], a[4 * q + 3]);
                            *(u32x2*)(Od + ri * 256 + h * 64 + e0) = w; } }
                }
    }
    asm volatile("s_waitcnt lgkmcnt(0)" ::: "memory"); __builtin_amdgcn_wave_barrier();
}
__device__ __forceinline__ void wyC_pass3(const Params& p, int task, int lane_) {
    const int lane = opq(lane_);
    const int c = task % 36, chain = task / 36, dir = chain & 1, h = (chain >> 1) & 3, b = chain >> 3, r = lane & 31, hh = lane >> 5;
    int rb, n, cc; chunk_rows(b, dir, c, rb, n, cc);
    const bf16_t* SI = (const bf16_t*)((const char*)p.out + 72 * MiB) + (size_t)task * 4096;
    const bf16_t* QE = (const bf16_t*)(p.ws + WS_H + 36 * MiB) + (size_t)task * 4096;
    bf16_t* Od = (bf16_t*)(p.ws + WS_X + X_OC) + (size_t)dir * TT * 256;
    bf16x8 sf[2][4], qf[2][4];
#pragma unroll
    for (int t = 0; t < 2; ++t)
#pragma unroll
        for (int s = 0; s < 4; ++s) { unsigned v[8];
#pragma unroll
            for (int jj = 0; jj < 8; ++jj) v[jj] = SI[(16 * s + 8 * hh + jj) * 64 + t * 32 + r];
            u32x4 w; w.x = v[0] | (v[1] << 16); w.y = v[2] | (v[3] << 16); w.z = v[4] | (v[5] << 16); w.w = v[6] | (v[7] << 16);
            sf[t][s] = __builtin_bit_cast(bf16x8, w);
            qf[t][s] = *(const bf16x8*)(QE + (t * 32 + r) * 64 + 16 * s + 8 * hh); }
    u32x2 ow_[2][2][4];
#pragma unroll
    for (int et = 0; et < 2; ++et)
#pragma unroll
        for (int it = 0; it < 2; ++it) { const size_t ri = WY_ROW(it * 32 + r);
#pragma unroll
            for (int q = 0; q < 4; ++q) ow_[et][it][q] = *(const u32x2*)(Od + ri * 256 + h * 64 + et * 32 + 8 * q + 4 * hh); }
    __builtin_amdgcn_sched_barrier(0);
#pragma unroll
    for (int et = 0; et < 2; ++et)
#pragma unroll
        for (int it = 0; it < 2; ++it) { f32x16 a;
#pragma unroll
            for (int i = 0; i < 16; ++i) a[i] = 0.f;
#pragma unroll
            for (int s = 0; s < 4; ++s) a = __builtin_amdgcn_mfma_f32_32x32x16_bf16(sf[et][s], qf[it][s], a, 0, 0, 0);
            const int i = it * 32 + r; const size_t ri = WY_ROW(i);
#pragma unroll
            for (int q = 0; q < 4; ++q) { bf16_t* op = Od + ri * 256 + h * 64 + et * 32 + 8 * q + 4 * hh; const u32x2 ow = ow_[et][it][q];
                u32x2 w; w.x = pg8::cvt_pk_bf16(bflo(ow.x) + a[4 * q], bfhi(ow.x) + a[4 * q + 1]); w.y = pg8::cvt_pk_bf16(bflo(ow.y) + a[4 * q + 2], bfhi(ow.y) + a[4 * q + 3]);
                *(u32x2*)op = w; } }
#undef WY_ROW
}
__device__ __forceinline__ float gla_gtable(const _Float16* LA, LAS float* G, int rb, int n, int cc, int dir, int h, int lane) {
    const int d = lane & 31, half = lane >> 5;
    float acc = 0.f, gl[32];
#pragma unroll
    for (int jj = 0; jj < 32; ++jj) { const int i = cc * 64 + 32 * half + jj; const size_t r = (size_t)(rb + (dir ? n - 1 - i : i)); gl[jj] = (float)LA[r * 256 + dir * 128 + h * 32 + d]; }
#pragma unroll
    for (int jj = 0; jj < 32; ++jj) { acc += gl[jj]; gl[jj] = acc; }
    float tlo, thi; { auto rr = __builtin_amdgcn_permlane32_swap(__float_as_uint(acc), __float_as_uint(acc), false, false); tlo = __uint_as_float(rr[0]); thi = __uint_as_float(rr[1]); }
    const float add = half ? tlo : 0.f;
#pragma unroll
    for (int jj = 0; jj < 32; ++jj) G[(32 * half + jj) * 32 + d] = gl[jj] + add;
    asm volatile("s_waitcnt lgkmcnt(0)" ::: "memory"); __builtin_amdgcn_wave_barrier();
    return tlo + thi;
}
#define TILE_TR_LOAD(tq_, ROWPTR_) do { _Pragma("unroll") for (int i_ = 0; i_ < 8; ++i_) { const int key_ = 8 * i_ + (lane >> 3); tq_[i_] = *(const u32x4*)(ROWPTR_(key_) + 8 * (lane & 7)); } } while (0)
#define TILE_TR_FRAGS(img_, tq_, f_) do { \
        _Pragma("unroll") for (int i_ = 0; i_ < 8; ++i_) *(LAS u32x4*)((img_) + (8 * i_ + (lane >> 3)) * 144 + (lane & 7) * 16) = tq_[i_]; \
        asm volatile("s_waitcnt lgkmcnt(0)" ::: "memory"); __builtin_amdgcn_wave_barrier(); \
        const LAS unsigned char* vb_ = (img_) + ((4 * (lane >> 5) + ((lane >> 2) & 3)) * 72 + 16 * ((lane >> 4) & 1) + 4 * (lane & 3)) * 2; \
        _Pragma("unroll") for (int s_ = 0; s_ < 4; ++s_) { \
            const u32x2 a0_ = vtr_read(vb_ + 16 * s_ * 144), a1_ = vtr_read(vb_ + (16 * s_ + 8) * 144), b0_ = vtr_read(vb_ + 16 * s_ * 144 + 64), b1_ = vtr_read(vb_ + (16 * s_ + 8) * 144 + 64); \
            f_[s_][0] = __builtin_bit_cast(bf16x8, (u32x4){a0_.x, a0_.y, a1_.x, a1_.y}); f_[s_][1] = __builtin_bit_cast(bf16x8, (u32x4){b0_.x, b0_.y, b1_.x, b1_.y}); } } while (0)
__device__ __forceinline__ void glaD_pass1(const Params& p, int task, LAS unsigned char* wl, int lane_) {
    const int lane = opq(lane_);
    const int c = task % 36, chain = task / 36, dir = chain & 1, h = (chain >> 1) & 3, b = chain >> 3, r = lane & 31, hh = lane >> 5;
    int rb, n, cc; chunk_rows(b, dir, c, rb, n, cc);
    const bf16_t* P = (const bf16_t*)(p.ws + WS_P); const _Float16* LA = (const _Float16*)(p.ws + WS_X + X_LA);
    float* DL = (float*)(p.ws + WS_DL) + (size_t)task * 2048; float* DV = (float*)(p.ws + WS_DV) + (size_t)task * 32;
    LAS float* G = (LAS float*)wl;
#define GL_ROW(i_) ((size_t)(rb + (dir ? n - 1 - (cc * 64 + (i_)) : cc * 64 + (i_))))
#define GL_VROW(k_) (P + GL_ROW(k_) * NPAD + C_DV + h * 64)
    u32x4 vtq[8]; TILE_TR_LOAD(vtq, GL_VROW);
    bf16_t kraw[4][8];
#pragma unroll
    for (int s = 0; s < 4; ++s)
#pragma unroll
        for (int jj = 0; jj < 8; ++jj) { const int j = 16 * s + 8 * (jj >> 2) + 4 * hh + (jj & 3); kraw[s][jj] = P[GL_ROW(j) * NPAD + C_DK + h * 32 + r]; }
    const float gtot = gla_gtable(LA, G, rb, n, cc, dir, h, lane);
    if (lane < 32) DV[lane] = __expf(gtot);
    bf16x8 af[4];
    __builtin_amdgcn_sched_barrier(0);
#pragma unroll
    for (int s = 0; s < 4; ++s) { float kv[8];
#pragma unroll
        for (int jj = 0; jj < 8; ++jj) { const int j = 16 * s + 8 * (jj >> 2) + 4 * hh + (jj & 3); kv[jj] = bf2f(kraw[s][jj]) * __expf(gtot - G[j * 32 + r]); }
        u32x4 w; w.x = pk2(kv[0], kv[1]); w.y = pk2(kv[2], kv[3]); w.z = pk2(kv[4], kv[5]); w.w = pk2(kv[6], kv[7]); af[s] = __builtin_bit_cast(bf16x8, w); }
    bf16x8 bfr[4][2];
    TILE_TR_FRAGS(wl + 8192, vtq, bfr);
#pragma unroll
    for (int ct = 0; ct < 2; ++ct) { f32x16 a;
#pragma unroll
        for (int i = 0; i < 16; ++i) a[i] = 0.f;
#pragma unroll
        for (int s = 0; s < 4; ++s) a = __builtin_amdgcn_mfma_f32_32x32x16_bf16(af[s], bfr[s][ct], a, 0, 0, 0);
#pragma unroll
        for (int i = 0; i < 16; ++i) DL[crow(i, hh) * 64 + ct * 32 + r] = a[i]; }
    asm volatile("s_waitcnt lgkmcnt(0)" ::: "memory"); __builtin_amdgcn_wave_barrier();
}
__device__ __forceinline__ void glaD_pass3(const Params& p, int task, LAS unsigned char* wl, int lane_) {
    const int lane = opq(lane_);
    const int c = task % 36, chain = task / 36, dir = chain & 1, h = (chain >> 1) & 3, b = chain >> 3, r = lane & 31, hh = lane >> 5;
    int rb, n, cc; chunk_rows(b, dir, c, rb, n, cc);
    const bf16_t* P = (const bf16_t*)(p.ws + WS_P); const _Float16* LA = (const _Float16*)(p.ws + WS_X + X_LA);
    const bf16_t* SI = (const bf16_t*)((const char*)p.out + 108 * MiB) + (size_t)task * 2048;
    bf16_t* Od = (bf16_t*)(p.ws + WS_H) + (size_t)dir * TT * 256;
    LAS float* G = (LAS float*)wl;
    u32x4 qraw[2][2], kraw[2][2]; unsigned sraw[2][2][8];
#pragma unroll
    for (int t = 0; t < 2; ++t)
#pragma unroll
        for (int s = 0; s < 2; ++s) { const int row = t * 32 + r, d0 = 16 * s + 8 * hh; const size_t gr = GL_ROW(row);
            qraw[t][s] = *(const u32x4*)(P + gr * NPAD + C_DQ + h * 32 + d0); kraw[t][s] = *(const u32x4*)(P + gr * NPAD + C_DK + h * 32 + d0);
#pragma unroll
            for (int jj = 0; jj < 8; ++jj) sraw[t][s][jj] = SI[(d0 + jj) * 64 + t * 32 + r]; }
    u32x4 vtq[8]; TILE_TR_LOAD(vtq, GL_VROW);
    (void)gla_gtable(LA, G, rb, n, cc, dir, h, lane);
    const float qscale = 0.17677669529663687f;
    bf16x8 qf[2][2], kf[2][2], sf[2][2];
#pragma unroll
    for (int t = 0; t < 2; ++t)
#pragma unroll
        for (int s = 0; s < 2; ++s) { const int row = t * 32 + r, d0 = 16 * s + 8 * hh; const size_t gr = GL_ROW(row);
            float qv[8], kv[8], gv[8], sv[8];
            unpack8(qraw[t][s], qv); unpack8(kraw[t][s], kv); (void)gr;
            { const f32x4 g0 = *(const LAS f32x4*)(G + row * 32 + d0), g1 = *(const LAS f32x4*)(G + row * 32 + d0 + 4); gv[0] = g0[0]; gv[1] = g0[1]; gv[2] = g0[2]; gv[3] = g0[3]; gv[4] = g1[0]; gv[5] = g1[1]; gv[6] = g1[2]; gv[7] = g1[3]; }
#pragma unroll
            for (int jj = 0; jj < 8; ++jj) { qv[jj] = qv[jj] * qscale * __expf(gv[jj]); kv[jj] = kv[jj] * __expf(-gv[jj]); }
            u32x4 w; w.x = pk2(qv[0], qv[1]); w.y = pk2(qv[2], qv[3]); w.z = pk2(qv[4], qv[5]); w.w = pk2(qv[6], qv[7]); qf[t][s] = __builtin_bit_cast(bf16x8, w);
            w.x = pk2(kv[0], kv[1]); w.y = pk2(kv[2], kv[3]); w.z = pk2(kv[4], kv[5]); w.w = pk2(kv[6], kv[7]); kf[t][s] = __builtin_bit_cast(bf16x8, w);
            w.x = sraw[t][s][0] | (sraw[t][s][1] << 16); w.y = sraw[t][s][2] | (sraw[t][s][3] << 16); w.z = sraw[t][s][4] | (sraw[t][s][5] << 16); w.w = sraw[t][s][6] | (sraw[t][s][7] << 16); sf[t][s] = __builtin_bit_cast(bf16x8, w); }
    f32x16 at[3];
#pragma unroll
    for (int tile = 0; tile < 3; ++tile) { const int jt = tile == 2, it = tile >= 1; f32x16 a;
#pragma unroll
        for (int i = 0; i < 16; ++i) a[i] = 0.f;
#pragma unroll
        for (int s = 0; s < 2; ++s) a = __builtin_amdgcn_mfma_f32_32x32x16_bf16(kf[jt][s], qf[it][s], a, 0, 0, 0);
        const int i = it * 32 + r;
#pragma unroll
        for (int q = 0; q < 16; ++q) { const int j = jt * 32 + crow(q, hh); a[q] = (j <= i) ? a[q] * 1.0f : 0.f; }
        at[tile] = a; }
    bf16x8 vf[4][2];
    TILE_TR_FRAGS(wl + 8192, vtq, vf);
#pragma unroll
    for (int et = 0; et < 2; ++et)
#pragma unroll
        for (int it = 0; it < 2; ++it) { f32x16 a;
#pragma unroll
            for (int i = 0; i < 16; ++i) a[i] = 0.f;
#pragma unroll
            for (int s = 0; s < 2; ++s) a = __builtin_amdgcn_mfma_f32_32x32x16_bf16(sf[et][s], qf[it][s], a, 0, 0, 0);
#pragma unroll
            for (int jt = 0; jt <= it; ++jt) { const f32x16& x = (jt == 0) ? (it == 0 ? at[0] : at[1]) : at[2];
#pragma unroll
                for (int s2 = 0; s2 < 2; ++s2) { u32x4 w; w.x = pk2(x[8 * s2], x[8 * s2 + 1]); w.y = pk2(x[8 * s2 + 2], x[8 * s2 + 3]); w.z = pk2(x[8 * s2 + 4], x[8 * s2 + 5]); w.w = pk2(x[8 * s2 + 6], x[8 * s2 + 7]);
                    a = __builtin_amdgcn_mfma_f32_32x32x16_bf16(vf[2 * jt + s2][et], __builtin_bit_cast(bf16x8, w), a, 0, 0, 0); } }
            const size_t ri = GL_ROW(it * 32 + r);
#pragma unroll
            for (int q = 0; q < 4; ++q) { u32x2 w; w.x = pk2(a[4 * q], a[4 * q + 1]); w.y = pk2(a[4 * q + 2], a[4 * q + 3]);
                *(u32x2*)(Od + ri * 256 + h * 64 + et * 32 + 8 * q + 4 * hh) = w; } }
    asm volatile("s_waitcnt lgkmcnt(0)" ::: "memory"); __builtin_amdgcn_wave_barrier();
#undef GL_VROW
#undef GL_ROW
}
__device__ __forceinline__ void chainC_item(const Params& p, int chain, float* lds, int wv) {
    const int tid = opq(TIDX(wv)), lane = tid & 63, wave = tid >> 6;
    float* Ms = lds;
    float* Xs = lds + 4096;
    float Sr[64];
#pragma unroll
    for (int d = 0; d < 64; ++d) Sr[d] = 0.f;
    __syncthreads();
    { f32x4* x4 = (f32x4*)Xs + tid * 2; x4[0] = (f32x4){0.f, 0.f, 0.f, 0.f}; x4[1] = (f32x4){0.f, 0.f, 0.f, 0.f}; }
    const f32x4* CM0 = (const f32x4*)((const float*)(p.ws + WS_CM) + (size_t)chain * 36 * 4096) + tid * 2; f32x4* CL0 = (f32x4*)((float*)(p.ws + WS_CL) + (size_t)chain * 36 * 4096) + tid * 2;
    f32x4 m0 = CM0[0], m1 = CM0[1], l0 = CL0[0], l1 = CL0[1];
    for (int c = 0; c < 36; ++c) {
        __syncthreads();
        { f32x4* mdst = (f32x4*)Ms + tid * 2; f32x4* x4 = (f32x4*)Xs + tid * 2; f32x4* cl4 = CL0 + (size_t)c * 1024; const f32x4 e0 = x4[0], e1 = x4[1];
            (void)cl4;
            { u32x4 w_; w_.x = pk2(e0[0], e0[1]); w_.y = pk2(e0[2], e0[3]); w_.z = pk2(e1[0], e1[1]); w_.w = pk2(e1[2], e1[3]);
              *(u32x4*)((bf16_t*)((char*)p.out + 72 * MiB) + ((size_t)chain * 36 + c) * 4096 + tid * 8) = w_; }
            x4[0] = l0; x4[1] = l1; mdst[0] = m0; mdst[1] = m1; }
        if (c + 1 < 36) { const f32x4* cm = CM0 + (size_t)(c + 1) * 1024; const f32x4* cl = CL0 + (size_t)(c + 1) * 1024; m0 = cm[0]; m1 = cm[1]; l0 = cl[0]; l1 = cl[1]; }
        __syncthreads();
#pragma unroll 1
        for (int k = 0; k < 8; ++k) { const int row = wave * 8 + k; const float* mr = Ms + row * 64; float a0 = 0.f, a1 = 0.f;
#pragma unroll
            for (int d4 = 0; d4 < 16; d4 += 2) { const f32x4 q0 = *(const f32x4*)(mr + d4 * 4), q1 = *(const f32x4*)(mr + d4 * 4 + 4);
                a0 += q0[0] * Sr[d4 * 4] + q0[1] * Sr[d4 * 4 + 1] + q0[2] * Sr[d4 * 4 + 2] + q0[3] * Sr[d4 * 4 + 3];
                a1 += q1[0] * Sr[d4 * 4 + 4] + q1[1] * Sr[d4 * 4 + 5] + q1[2] * Sr[d4 * 4 + 6] + q1[3] * Sr[d4 * 4 + 7]; }
            Xs[row * 64 + lane] += a0 + a1; }
        __syncthreads();
#pragma unroll
        for (int d = 0; d < 64; ++d) Sr[d] = Xs[d * 64 + lane];
    }
    __syncthreads();
}
__device__ __forceinline__ void chainD_item(const Params& p, int chain, int wv) {
    const int tid = opq(TIDX(wv));
    f32x4 S = (f32x4){0.f, 0.f, 0.f, 0.f};
    f32x4* DL = (f32x4*)((float*)(p.ws + WS_DL) + (size_t)chain * 36 * 2048) + tid; const float* DV = (const float*)(p.ws + WS_DV) + (size_t)chain * 36 * 32 + (tid >> 4);
#pragma unroll 1
    for (int c0 = 0; c0 < 36; c0 += 12) {
        f32x4 loc[12]; float dv[12];
#pragma unroll
        for (int i = 0; i < 12; ++i) { loc[i] = DL[(size_t)(c0 + i) * 512]; dv[i] = DV[(c0 + i) * 32]; }
#pragma unroll
        for (int i = 0; i < 12; ++i) { u32x2 w_; w_.x = pk2(S[0], S[1]); w_.y = pk2(S[2], S[3]);
            *(u32x2*)((bf16_t*)((char*)p.out + 108 * MiB) + ((size_t)chain * 36 + c0 + i) * 2048 + tid * 4) = w_; S = S * dv[i] + loc[i]; }
    }
}
__device__ __forceinline__ void ph_mixers1(const Params& p, int l, float* lds, int bid, int nb, int wv) {
    const int tid = opq(TIDX(wv)), lane = tid & 63, wave = tid >> 6;
    float* wl = lds + wave * (WY_LDS / 4);
    const int gw = wv * nb + bid, NGW = nb * 8;
    {
    { LAS unsigned char* wl3 = (LAS unsigned char*)lds + wv * WY_LDS;
      for (int t = gw; t < 9216; t += NGW) { if (t < 4608) wyC_pass1(p, t, wl3, lane); else glaD_pass1(p, t - 4608, wl3, lane); } }
    }
    __syncthreads();
    LAS unsigned char* lds3 = (LAS unsigned char*)lds;
    for (int rp = 0; rp < 1 + ((PROBE_MASK >> 15) & 1); ++rp)
    for (int it = bid; it < 512; it += nb) { const int b = it >> 5, g = (it >> 4) & 1, qb = it & 15, hq = 2 * g + (wave >> 2);
        attn_mfma_unit<true>(p, lds3, b * 2048 + qb * 128 + (wave & 3) * 32, C_AQ + hq * 64, hq * 64, C_AK + g * 64, C_AV + g * 64, b * 2048, 2048, TL + b * 256, 256, wv); }
}
constexpr int WQ_MAIN = WI2 - WI0;
constexpr int Q_CTX = 256, Q_NA = Q_CTX + 128, Q_WC = Q_NA + 512, Q_RT = Q_WC + (WQ_MAIN + 63) / 64, Q_END = Q_RT + 1;
constexpr int WQ2_PULLS = (WI5 - WI2) / 16, WQ3_PULLS = WI0 / 16;
__device__ __forceinline__ void wconv_steal_q(const Params& p, int lw, int first, int npulls, unsigned* ctr, float* lds, LAS int* tab, int npull, int wv) {
    const int tid = opq(TIDX(wv)), lane = tid & 63, wave = tid >> 6;
    float* scr = lds + wave * 2112;
    for (int k = 0; npull < 0 || k < npull; ++k) {
        __syncthreads();
        if (tid == 0) tab[62] = (int)atomicAdd(ctr, 1u);
        __syncthreads();
        const int it = tab[62];
        if (it >= npulls) break;
        wconv_wave_item(p, lw, first + it * 16 + wave, scr, lane); wconv_wave_item(p, lw, first + it * 16 + 8 + wave, scr, lane);
    }
    __syncthreads();
}
__device__ __forceinline__ void wconv_steal(const Params& p, int l, float* lds, LAS int* tab, int npull, int wv) {
    wconv_steal_q(p, l, WI2, WQ2_PULLS, (unsigned*)(p.ws + WS_CTL) + CW_Q + l * 64 + 16, lds, tab, npull, wv); }
__device__ __forceinline__ void wconv_steal_in(const Params& p, int l, float* lds, LAS int* tab, int npull, int wv) {
    if (l + 1 < NL) wconv_steal_q(p, l + 1, 0, WQ3_PULLS, (unsigned*)(p.ws + WS_CTL) + CW_Q + l * 64 + 24, lds, tab, npull, wv); }
__device__ __forceinline__ void ph_mixers2(const Params& p, int l, float* lds, LAS int* tab, int bid, int nb, int wv) {
    const int tid = opq(TIDX(wv)), lane = tid & 63, wave = tid >> 6;
    LAS unsigned char* lds3 = (LAS unsigned char*)lds;
    unsigned* qctr = (unsigned*)(p.ws + WS_CTL) + CW_Q + l * 64;
    for (;;) {
        __syncthreads();
        if (tid == 0) tab[60] = (int)atomicAdd(qctr, 1u);
        __syncthreads();
        const int it = tab[60];
        if (it >= Q_END) break;
        if (it < 128) chainC_item(p, it, lds, wv);
        else if (it < 256) chainD_item(p, it - 128, wv);
        else if (it < Q_NA) { const int u = it - Q_CTX;
            if (l == NL - 1) { }
            else if (u < 64) { const int b = u >> 2, g = (u >> 1) & 1, qb = u & 1, hq = 2 * g + (wave >> 2);
                attn_mfma_unit<true>(p, lds3, TL + b * 256 + qb * 128 + (wave & 3) * 32, C_AQ + hq * 64, hq * 64, C_AK + g * 64, C_AV + g * 64, TL + b * 256, 256, 0, 0, wv); }
            else { const int b = (u - 64) >> 2, hb = u & 3;
                attn_mfma_unit<false>(p, lds3, TL + b * 256 + wave * 32, C_BQ + hb * 64, 256 + hb * 64, C_BK + hb * 64, C_BV + hb * 64, TL + b * 256, 256, 0, 0, wv); } }
        else if (it < Q_WC) { const int u = it - Q_NA, b = u >> 5, hb = (u >> 3) & 3, rg = u & 7; attn_na_unit(p, lds3, l, b, hb, rg, wv); }
        else if (it < Q_RT) { float* scr = lds + wave * 2112;
            for (int k = 0; k < 8; ++k) { const int wi = (it - Q_WC) * 64 + k * 8 + wave;
                if (wi < WQ_MAIN) wconv_wave_item(p, l, WI0 + wi, scr, lane); } }
        else router_relayout(p, l, tid);
    }
    if (l == NL - 1) wconv_steal(p, l, lds, tab, -1, wv);
}
__device__ __forceinline__ void ph_mixers3(const Params& p, int l, float* lds, int bid, int nb, int wv) {
    const int tid = opq(TIDX(wv)), lane = tid & 63, wave = tid >> 6;
    float* wl = lds + wave * 3200;
    const int gw = wv * nb + bid, NGW = nb * 8;
    { LAS unsigned char* wl3 = (LAS unsigned char*)lds + wv * WY_LDS;
      for (int t = gw; t < 9216; t += NGW) { const int tk = t < 4608 ? t : t - 4608;
          if (l == NL - 1 && tk % 36 < 4) continue;
          if (t < 4608) wyC_pass3(p, tk, lane); else glaD_pass3(p, tk, wl3, lane); } }
}
__device__ __forceinline__ void ph_gated(const Params& p, int l, int bid, int nb, int wv) {
    const int tid = opq(TIDX(wv)), lane = tid & 63, wave = tid >> 6;
    const bf16_t* P = (const bf16_t*)(p.ws + WS_P); bf16_t* O = (bf16_t*)(p.ws + WS_O);
    const bf16_t* OC = (const bf16_t*)(p.ws + WS_X + X_OC); const bf16_t* OD = (const bf16_t*)(p.ws + WS_H);
    const f32x4 cg = *(const f32x4*)(p.in[I_COG] + l * 64 + (lane & 15) * 4), dg = *(const f32x4*)(p.in[I_DOG] + l * 64 + (lane & 15) * 4);
    for (int r0 = (bid * 8 + wave) * 2; r0 < (l == NL - 1 ? TL : TT); r0 += nb * 16) {
        u32x2 a[2][2], b[2][2], g[2][2];
#pragma unroll
        for (int q = 0; q < 2; ++q)
#pragma unroll
            for (int mix = 0; mix < 2; ++mix) { const bf16_t* od = mix ? OD : OC; const size_t r = (size_t)(r0 + q);
                a[q][mix] = *(const u32x2*)(od + r * 256 + lane * 4); b[q][mix] = *(const u32x2*)(od + (size_t)TT * 256 + r * 256 + lane * 4);
                g[q][mix] = *(const u32x2*)(P + r * NPAD + (mix ? C_DG : C_CG) + lane * 4); }
#pragma unroll
        for (int q = 0; q < 2; ++q)
#pragma unroll
            for (int mix = 0; mix < 2; ++mix) {
                float o[4] = {bflo(a[q][mix].x) + bflo(b[q][mix].x), bfhi(a[q][mix].x) + bfhi(b[q][mix].x), bflo(a[q][mix].y) + bflo(b[q][mix].y), bfhi(a[q][mix].y) + bfhi(b[q][mix].y)};
                const float gt[4] = {bflo(g[q][mix].x), bfhi(g[q][mix].x), bflo(g[q][mix].y), bfhi(g[q][mix].y)};
                float ss = (o[0] * o[0] + o[1] * o[1]) + (o[2] * o[2] + o[3] * o[3]);
                ss = row16_sum(ss);
                const float rn = rsqrtf(ss * (1.f / 64.f) + EPS); const f32x4 gn = mix ? dg : cg;
#pragma unroll
                for (int e = 0; e < 4; ++e) o[e] = o[e] * rn * gn[e] * silu_f(gt[e]);
                u32x2 w; w.x = pk2(o[0], o[1]); w.y = pk2(o[2], o[3]);
                *(u32x2*)(O + (size_t)(r0 + q) * D + 512 + mix * 256 + lane * 4) = w; }
    }
}
constexpr int LN1_R = 2;
__device__ __forceinline__ void ph_ln1_route(const Params& p, int l, int M, LAS unsigned char* lds3, LAS int* tab, int bid, int nb, int wv, int dry = 0) {
    const int tid = opq(TIDX(wv)), lane = tid & 63, wave = tid >> 6;
    const bf16_t* Y = (const bf16_t*)(p.ws + WS_X + X_Y);
    bf16_t* H = dry ? (bf16_t*)(p.ws + WS_CL) : (bf16_t*)(p.ws + WS_H);
    const float* mod = (const float*)(p.ws + WS_MOD) + (size_t)l * 17 * 6144;
    const float* lg_ = p.in[I_LN1G] + l * D; const float* lb_ = p.in[I_LN1B] + l * D;
    const float* wrg0 = (const float*)(p.ws + WS_W + W_RG);
    unsigned* cnt = (unsigned*)(p.ws + WS_CTL) + CW_CNT + l * 32 + (dry ? 1024 : 0);
    int* lists = dry ? (int*)(p.ws + WS_DL) : (int*)(p.ws + WS_LIST); float* wt = dry ? (float*)(p.ws + WS_DL) + 8 * 1024 * 1024 : (float*)(p.ws + WS_WT);
    LAS int* lcnt = tab + 64; LAS int* gbase = tab + 96; LAS int* rec = tab + 128;
    __syncthreads();
    if (tid < 32) lcnt[tid] = 0;
    {
        const f32x4* RE4 = (const f32x4*)(p.ws + WS_W + W_RE);
        {   f32x4 tmp_[16];
#pragma unroll
            for (int k = 0; k < 16; ++k) tmp_[k] = RE4[tid + k * NTHR];
            __builtin_amdgcn_sched_barrier(0);
#pragma unroll
            for (int k = 0; k < 16; ++k) { const int i4 = tid + k * NTHR, blk = i4 >> 7, off = i4 & 127, ln = off >> 1, kh = off & 1;
                *(LAS f32x4*)(lds3 + (unsigned)(blk * 512 + kh * 256 + ln * 4) * 4u) = tmp_[k]; } }
        {   float ga_[6], gb_[6];
#pragma unroll
            for (int k = 0; k < 6; ++k) { const int i = tid + k * NTHR, e = i & 3, ln = (i >> 2) & 63, j = (i >> 8) & 3, g1 = i >> 10; const float* s_ = wrg0 + ((j * 4 + e) * 64 + ln) * 4;
                ga_[k] = s_[g1 + 1]; gb_[k] = s_[0]; }
            __builtin_amdgcn_sched_barrier(0);
#pragma unroll
            for (int k = 0; k < 6; ++k) *(LAS float*)(lds3 + 131072u + (unsigned)(tid + k * NTHR) * 4u) = ga_[k] - gb_[k]; } }
    __syncthreads();
    int kit = 0;
    const float brg_l = p.in[I_BRG][l * 4 + (lane & 3)], bre_l = p.in[I_BRE][l * 32 + (lane & 31)];
    f32x4 g4r[4], b4r[4];
#pragma unroll
    for (int j = 0; j < 4; ++j) { g4r[j] = *(const f32x4*)(lg_ + j * 256 + lane * 4); b4r[j] = *(const f32x4*)(lb_ + j * 256 + lane * 4); }
    h16x4 xq[LN1_R][4]; u32x2 yq[LN1_R][4];
#define LN1_FETCH(r_) do { _Pragma("unroll") for (int q_ = 0; q_ < LN1_R; ++q_) _Pragma("unroll") for (int j_ = 0; j_ < 4; ++j_) { \
        xq[q_][j_] = *(const h16x4*)((const _Float16*)p.out + (size_t)((r_) + q_) * D + j_ * 256 + lane * 4); yq[q_][j_] = *(const u32x2*)(Y + (size_t)((r_) + q_) * D + j_ * 256 + lane * 4); } } while (0)
    { const int rf = (bid * 8 + wave) * LN1_R; if (rf < M) LN1_FETCH(rf); }
    for (int r0 = (bid * 8 + wave) * LN1_R; r0 < M; r0 += nb * 8 * LN1_R, ++kit) {
        const float* m = mod + (size_t)brow(r0) * 6144;
        f32x4 s2r[4], sh2r[4];
#pragma unroll
        for (int j = 0; j < 4; ++j) { s2r[j] = *(const f32x4*)(m + 4096 + j * 256 + lane * 4); sh2r[j] = *(const f32x4*)(m + 3072 + j * 256 + lane * 4); }
        float v[LN1_R][16]; float s[LN1_R];
#pragma unroll
        for (int q = 0; q < LN1_R; ++q) { s[q] = 0.f;
#pragma unroll
            for (int j = 0; j < 4; ++j) { const int c = j * 256 + lane * 4; const f32x4 xv = __builtin_convertvector(xq[q][j], f32x4);
                const f32x4 gv = *(const f32x4*)(m + 2048 + c);
                const u32x2 yw = yq[q][j]; const float yv[4] = {bflo(yw.x), bfhi(yw.x), bflo(yw.y), bfhi(yw.y)};
#pragma unroll
                for (int e = 0; e < 4; ++e) { v[q][j * 4 + e] = DN_ALPHA * xv[e] + gv[e] * yv[e]; s[q] += v[q][j * 4 + e]; } } }
        float qq[LN1_R];
#pragma unroll
        for (int q = 0; q < LN1_R; ++q) { const float mean = wave_sum(s[q]) * (1.f / D); qq[q] = 0.f;
#pragma unroll
            for (int i = 0; i < 16; ++i) { v[q][i] -= mean; qq[q] += v[q][i] * v[q][i]; } }
#pragma unroll
        for (int q = 0; q < LN1_R; ++q) { const float rstd = rsqrtf(wave_sum(qq[q]) * (1.f / D) + EPS); _Float16* x1 = (_Float16*)(p.ws + (dry ? WS_CM : WS_O)) + (size_t)(r0 + q) * D;
#pragma unroll
            for (int j = 0; j < 4; ++j) { const int c = j * 256 + lane * 4; const f32x4 g4 = g4r[j], b4 = b4r[j], s2 = s2r[j], sh2 = sh2r[j];
                f32x4 o;
#pragma unroll
                for (int e = 0; e < 4; ++e) { o[e] = v[q][j * 4 + e] * rstd * g4[e] + b4[e]; v[q][j * 4 + e] = o[e] * (1.f + s2[e]) + sh2[e]; }
                sth4(x1 + c, o);
                u32x2 hw; hw.x = pk2(v[q][j * 4], v[q][j * 4 + 1]); hw.y = pk2(v[q][j * 4 + 2], v[q][j * 4 + 3]); *(u32x2*)(H + (size_t)(r0 + q) * D + c) = hw; } }
        __builtin_amdgcn_sched_barrier(0);
        { const int rn = r0 + nb * 8 * LN1_R; if (rn < M) LN1_FETCH(rn); }
        __builtin_amdgcn_sched_barrier(0);
        float lg[LN1_R][4];
#pragma unroll
        for (int q = 0; q < LN1_R; ++q)
#pragma unroll
            for (int g = 0; g < 4; ++g) lg[q][g] = 0.f;
        { f32x4 wgq[4][3];
#pragma unroll
          for (int j = 0; j < 4; ++j)
#pragma unroll
              for (int g1 = 0; g1 < 3; ++g1) wgq[j][g1] = *(const LAS f32x4*)(lds3 + 131072u + (unsigned)(((g1 * 4 + j) * 64 + lane) * 16));
          __builtin_amdgcn_sched_barrier(0);
#pragma unroll
          for (int j = 0; j < 4; ++j)
#pragma unroll
              for (int g1 = 0; g1 < 3; ++g1)
#pragma unroll
                  for (int q = 0; q < LN1_R; ++q)
#pragma unroll
                      for (int e = 0; e < 4; ++e) lg[q][g1 + 1] += v[q][j * 4 + e] * wgq[j][g1][e];
          __builtin_amdgcn_sched_barrier(0); }
        int grp[LN1_R]; float pgrp[LN1_R];
#pragma unroll
        for (int q = 0; q < LN1_R; ++q) {
#pragma unroll
            for (int g = 1; g < 4; ++g) lg[q][g] = wave_sum(lg[q][g]) + (__int_as_float(__builtin_amdgcn_readlane(__float_as_int(brg_l), g)) - __int_as_float(__builtin_amdgcn_readlane(__float_as_int(brg_l), 0)));
            grp[q] = 0; float gm = lg[q][0];
#pragma unroll
            for (int g = 1; g < 4; ++g) if (lg[q][g] > gm) { gm = lg[q][g]; grp[q] = g; }
            float gs = 0.f;
#pragma unroll
            for (int g = 0; g < 4; ++g) gs += expf(lg[q][g] - gm);
            pgrp[q] = 1.f / gs; }
        float ev[LN1_R][8];
#pragma unroll
        for (int q = 0; q < LN1_R; ++q) { const LAS float* wre_g = (const LAS float*)lds3 + grp[q] * 8192 + lane * 4;
#pragma unroll
            for (int k = 0; k < 8; ++k) ev[q][k] = 0.f;
#pragma unroll
            for (int j = 0; j < 4; ++j) { f32x4 w0[4], w1[4];
#pragma unroll
                for (int e = 0; e < 4; ++e) { w0[e] = *(const LAS f32x4*)(wre_g + (j * 4 + e) * 512); w1[e] = *(const LAS f32x4*)(wre_g + (j * 4 + e) * 512 + 256); }
                __builtin_amdgcn_sched_barrier(0);
#pragma unroll
                for (int e = 0; e < 4; ++e) { const float hv = v[q][j * 4 + e];
#pragma unroll
                    for (int k = 0; k < 4; ++k) { ev[q][k] += hv * w0[e][k]; ev[q][4 + k] += hv * w1[e][k]; } }
                __builtin_amdgcn_sched_barrier(0); } }
        int ea[LN1_R], eb[LN1_R]; float w0s[LN1_R], w1s[LN1_R];
#pragma unroll
        for (int q = 0; q < LN1_R; ++q) {
#pragma unroll
            for (int k = 0; k < 8; ++k) ev[q][k] = wave_sum(ev[q][k]) + __int_as_float(__builtin_amdgcn_readlane(__float_as_int(bre_l), __builtin_amdgcn_readfirstlane(grp[q]) * 8 + k));
            int i0 = 0; float m0 = ev[q][0];
#pragma unroll
            for (int k = 1; k < 8; ++k) if (ev[q][k] > m0) { m0 = ev[q][k]; i0 = k; }
            int i1 = -1; float m1 = -INFINITY;
#pragma unroll
            for (int k = 0; k < 8; ++k) if (k != i0 && ev[q][k] > m1) { m1 = ev[q][k]; i1 = k; }
            if (i1 < 0) i1 = (i0 + 1) & 7;
            const float e1 = expf(m1 - m0);
            w0s[q] = pgrp[q] / (1.f + e1); w1s[q] = pgrp[q] * e1 / (1.f + e1); ea[q] = grp[q] * 8 + i0; eb[q] = grp[q] * 8 + i1; }
        if (lane == 0) {
#pragma unroll
            for (int q = 0; q < LN1_R; ++q) { const int r = r0 + q, li = (kit * 8 + wave) * LN1_R + q;
                const int sa = __hip_atomic_fetch_add(lcnt + ea[q], 1, __ATOMIC_RELAXED, __HIP_MEMORY_SCOPE_WORKGROUP), sb = __hip_atomic_fetch_add(lcnt + eb[q], 1, __ATOMIC_RELAXED, __HIP_MEMORY_SCOPE_WORKGROUP);
                rec[li * 4] = ea[q]; rec[li * 4 + 1] = sa; rec[li * 4 + 2] = eb[q]; rec[li * 4 + 3] = sb; wt[r * 2] = w0s[q]; wt[r * 2 + 1] = w1s[q]; }
        }
    }
    __syncthreads();
    if (tid < 32) gbase[tid] = (int)atomicAdd(cnt + tid, (unsigned)lcnt[tid]);
    __syncthreads();
    {
        const int nrows_blk = ((M + nb * 8 * LN1_R - 1) / (nb * 8 * LN1_R)) * 8 * LN1_R;
        for (int i = tid; i < nrows_blk * 2; i += NTHR) { const int li = i >> 1, k = i & 1;
            const int q = li % LN1_R, w8 = (li / LN1_R) & 7, kk = li / (8 * LN1_R);
            const int r = (bid * 8 + w8) * LN1_R + kk * (nb * 8 * LN1_R) + q;
            if (r < M) { const int e = rec[li * 4 + 2 * k], s = rec[li * 4 + 2 * k + 1]; lists[(size_t)e * (TT * 2) + gbase[e] + s] = r * 2 + k; } }
    }
}
__device__ __forceinline__ void moe_table(const Params& p, int l, LAS int* ts, int wv) {
    const unsigned* cnt = (const unsigned*)(p.ws + WS_CTL) + CW_CNT + l * 32;
    if (wv == 0) {
        const int ln = lane_now(); const int tl = (ln < 32) ? (((int)cnt[ln & 31] + 255) >> 8) : 0; int a = 0, mine = 0;
#pragma unroll
        for (int e = 0; e < NEXP; ++e) { const int te = __builtin_amdgcn_readlane(tl, e); mine = (ln == e) ? a : mine; a += te; }
        if (ln < 32) ts[ln] = mine;
        if (ln == 32) ts[32] = a; }
    __syncthreads();
}
__device__ __forceinline__ void ph_ln2(const Params& p, int l, int M, int bid, int nb, int wv, int dry = 0) {
    const int tid = opq(TIDX(wv)), lane = tid & 63, wave = tid >> 6;
    const bf16_t* Ye = (const bf16_t*)(p.ws + WS_P + P_YE);
    const float* wt = (const float*)(p.ws + WS_WT);
    const float* mod = (const float*)(p.ws + WS_MOD) + (size_t)l * 17 * 6144;
    const float* lg_ = p.in[I_LN2G] + l * D; const float* lb_ = p.in[I_LN2B] + l * D;
    const float* wt_ = wt;
    f32x4 g4[4], b4[4];
#pragma unroll
    for (int j = 0; j < 4; ++j) { g4[j] = *(const f32x4*)(lg_ + j * 256 + lane * 4); b4[j] = *(const f32x4*)(lb_ + j * 256 + lane * 4); }
    for (int r0 = (bid * 8 + wave) * 2; r0 < M; r0 += nb * 16) {
        const float* m = mod + (size_t)brow(r0) * 6144;
        const float* mn = mod + 17 * 6144 + (size_t)brow(r0) * 6144;
        f32x4 s1n[4], shn[4];
        if (l + 1 < NL) {
#pragma unroll
            for (int j = 0; j < 4; ++j) { s1n[j] = *(const f32x4*)(mn + 1024 + j * 256 + lane * 4); shn[j] = *(const f32x4*)(mn + j * 256 + lane * 4); } }
        else {
#pragma unroll
            for (int j = 0; j < 4; ++j) { s1n[j] = (f32x4){0.f, 0.f, 0.f, 0.f}; shn[j] = s1n[j]; } }
        float v[2][16], s[2];
#pragma unroll
        for (int q = 0; q < 2; ++q) { const int r = r0 + q; const _Float16* x1 = (const _Float16*)(p.ws + WS_O) + (size_t)r * D;
            const float w0 = wt_[r * 2], w1 = wt_[r * 2 + 1];
            const bf16_t* y0p = Ye + (size_t)(r * 2) * D; const bf16_t* y1p = Ye + (size_t)(r * 2 + 1) * D;
            s[q] = 0.f;
#pragma unroll
            for (int j = 0; j < 4; ++j) { const int c = j * 256 + lane * 4; const f32x4 xv = ldh4(x1 + c), gv = *(const f32x4*)(m + 5120 + c);
                const u32x2 a = *(const u32x2*)(y0p + c), b = *(const u32x2*)(y1p + c);
                const float y0[4] = {bflo(a.x), bfhi(a.x), bflo(a.y), bfhi(a.y)}, y1[4] = {bflo(b.x), bfhi(b.x), bflo(b.y), bfhi(b.y)};
#pragma unroll
                for (int e = 0; e < 4; ++e) { v[q][j * 4 + e] = DN_ALPHA * xv[e] + gv[e] * (w0 * y0[e] + w1 * y1[e]); s[q] += v[q][j * 4 + e]; } } }
        float qq[2];
#pragma unroll
        for (int q = 0; q < 2; ++q) { const float mean = wave_sum(s[q]) * (1.f / D); qq[q] = 0.f;
#pragma unroll
            for (int i = 0; i < 16; ++i) { v[q][i] -= mean; qq[q] += v[q][i] * v[q][i]; } }
        bf16_t* Hn = dry ? (bf16_t*)(p.ws + WS_CL) : (bf16_t*)(p.ws + WS_H);
#pragma unroll
        for (int q = 0; q < 2; ++q) { const int r = r0 + q; const float rstd = rsqrtf(wave_sum(qq[q]) * (1.f / D) + EPS);
#pragma unroll
            for (int j = 0; j < 4; ++j) { const int c = j * 256 + lane * 4; f32x4 o;
#pragma unroll
                for (int e = 0; e < 4; ++e) o[e] = v[q][j * 4 + e] * rstd * g4[j][e] + b4[j][e];
                if (l + 1 >= NL) *(f32x4*)((dry ? (float*)(p.ws + WS_CM) + (size_t)(r & 8191) * D : p.out + (size_t)r * D) + c) = o;
                else { sth4((dry ? (_Float16*)(p.ws + WS_CM) : (_Float16*)p.out) + (size_t)r * D + c, o);
                    const f32x4 s1 = s1n[j], sh = shn[j];
                    u32x2 hw; hw.x = pk2(o[0] * (1.f + s1[0]) + sh[0], o[1] * (1.f + s1[1]) + sh[1]); hw.y = pk2(o[2] * (1.f + s1[2]) + sh[2], o[3] * (1.f + s1[3]) + sh[3]);
                    *(u32x2*)(Hn + (size_t)r * D + c) = hw; } } }
    }
}

__global__ void __launch_bounds__(NTHR, 2) fwd_kernel(Params p) {
    extern __shared__ __attribute__((aligned(16))) unsigned char smem[];
    float* lds = (float*)smem;
    LAS unsigned char* lds3 = (LAS unsigned char*)smem;
    volatile LAS unsigned* misc = (volatile LAS unsigned*)(lds3 + LDS_MISC);
    LAS int* ts = (LAS int*)(lds3 + LDS_TAB);
    const int tid = threadIdx.x, bid = blockIdx.x, nb = gridDim.x;
    const int wv = __builtin_amdgcn_readfirstlane(tid >> 6);
    if (tid < 4) misc[tid] = 0u;
    __syncthreads();
#if defined(__HIP_DEVICE_COMPILE__)
#define WSPTR() (kp_get()->ws)
#else
#define WSPTR() (p.ws)
#endif
#if MK_SINGLE
    { XcdBarrier b0 = xcd_barrier_post((unsigned*)(WSPTR() + WS_CTL) + CW_BAR, misc); (void)b0; }
#endif
    const int lo = p.ph_lo, hi = p.ph_hi; (void)lo; (void)hi;
#if MK_SINGLE
#define IN(k) true
#define SEAM(k) do { if ((k) + 1 < NPH) { XcdBarrier b_; b_.bar = (unsigned*)(WSPTR() + WS_CTL) + CW_BAR; b_.x = xb_xcc_id(); b_.st = misc; xcd_barrier(b_, wv); } } while (0)
#else
#define IN(k) (lo <= (k) && (k) < hi)
#define SEAM(k) do { } while (0)
#endif
    if (IN(0)) { LOADP(); ph_init(q, lds, bid, nb, wv); }
    SEAM(0);
#define H_ ((bf16_t*)(q.ws + WS_H))
#define P_ ((bf16_t*)(q.ws + WS_P))
#define O_ ((bf16_t*)(q.ws + WS_O))
#define Mg_ ((bf16_t*)(q.ws + WS_X + X_MG))
#define Yb_ ((bf16_t*)(q.ws + WS_X + X_Y))
#define As_ ((bf16_t*)(q.ws + WS_P + P_AS))
#define Hid_ ((bf16_t*)(q.ws + WS_P + P_HID))
#define Yexp_ ((bf16_t*)(q.ws + WS_P + P_YE))
    for (int l = 0; l < NL; ++l) {
        const int base = 1 + l * NPL;
        const int M2 = (l == NL - 1) ? TL : TT;
        if (l == 0) { { LOADP(); ph_wconv_mod(q, l, lds, bid, nb, wv); }
        SEAM(base + 0); }
        for (int rep_ = 0; rep_ < 1 + ((PROBE_MASK >> 1) & 1); ++rep_) { LOADP();
            pg8::Gemm g{H_, (const bf16_t*)(q.ws + WS_W + W_IN), TT, NPAD, D, D, D, 0}; pg8::StaticOrder S; S.init(TT, NPAD, nb, bid);
            pg8::EpiStore E{P_, NPAD};
            pg8::gemm_phase<pg8::EpiStore, pg8::StaticOrder>(lds3, g, S, E, wv);
            { const int nwg_ = (TT / 256) * (NPAD / 256); if ((nwg_ - bid + nb - 1) / nb < (nwg_ + nb - 1) / nb) wconv_steal(q, l, lds, ts, 3, wv); } }
        SEAM(base + 1);
        for (int rep_ = 0; rep_ < 1 + ((PROBE_MASK >> 2) & 1); ++rep_) { LOADP(); if ((PROBE_MASK >> 17) & 1) ph_prep(q, l, bid, nb, wv, 1); ph_prep(q, l, bid, nb, wv); }
        SEAM(base + 2);
        for (int rep_ = 0; rep_ < 1 + ((PROBE_MASK >> 3) & 1); ++rep_) { LOADP(); ph_mixers1(q, l, lds, bid, nb, wv); }
        SEAM(base + 3);
        for (int rep_ = 0; rep_ < 1 + ((PROBE_MASK >> 4) & 1); ++rep_) { LOADP(); ph_mixers2(q, l, lds, ts, bid, nb, wv); }
        SEAM(base + 4);
        for (int rep_ = 0; rep_ < 1 + ((PROBE_MASK >> 5) & 1); ++rep_) { LOADP(); ph_mixers3(q, l, lds, bid, nb, wv); }
        SEAM(base + 5);
        for (int rep_ = 0; rep_ < 1 + ((PROBE_MASK >> 6) & 1); ++rep_) { LOADP(); ph_gated(q, l, bid, nb, wv); }
        SEAM(base + 6);
        for (int rep_ = 0; rep_ < 1 + ((PROBE_MASK >> 7) & 1); ++rep_) { LOADP();
            pg8::GatedMerge g{O_, (const bf16_t*)(q.ws + WS_W + W_BR), P_ + C_GATES, NPAD, Mg_, M2};
            pg8::gemm_gated_phase(lds3, g, nb, bid, wv);
            { const int nwg_ = (M2 / 256) * 8; if ((nwg_ - bid + nb - 1) / nb < (nwg_ + nb - 1) / nb) wconv_steal(q, l, lds, ts, 6, wv); } }
        SEAM(base + 7);
        for (int rep_ = 0; rep_ < 1 + ((PROBE_MASK >> 8) & 1); ++rep_) { LOADP();
            pg8::Gemm g{Mg_, (const bf16_t*)(q.ws + WS_W + W_OUT), M2, D, D, D, D, 0}; pg8::StaticOrder S; S.init(M2, D, nb, bid);
            pg8::EpiStore E{Yb_, D};
            pg8::gemm_phase<pg8::EpiStore, pg8::StaticOrder>(lds3, g, S, E, wv);
            { const int nwg_ = (M2 / 256) * 4; if ((nwg_ - bid + nb - 1) / nb < (nwg_ + nb - 1) / nb) wconv_steal(q, l, lds, ts, 3, wv); } }
        SEAM(base + 8);
        for (int rep_ = 0; rep_ < 1 + ((PROBE_MASK >> 9) & 1); ++rep_) { LOADP(); wconv_steal(q, l, lds, ts, -1, wv); if ((PROBE_MASK >> 18) & 1) ph_ln1_route(q, l, M2, lds3, ts, bid, nb, wv, 1); ph_ln1_route(q, l, M2, lds3, ts, bid, nb, wv); }
        SEAM(base + 9);
        for (int rep_ = 0; rep_ < 1 + ((PROBE_MASK >> 11) & 1); ++rep_) { LOADP();
            moe_table(q, l, ts, wv);
            pg8::Gemm g{H_, (const bf16_t*)(q.ws + WS_W + W_GU), MOE_ROWS, 1024, D, D, D, (size_t)1024 * 1024};
            pg8::ExpertOrder S{4, nb, bid, ts, (const unsigned*)(q.ws + WS_CTL) + CW_CNT + l * 32, (const int*)(q.ws + WS_LIST)};
            pg8::EpiSwiglu E{Hid_, EH};
            pg8::gemm_phase_gather<pg8::EpiSwiglu, pg8::ExpertOrder>(lds3, g, S, E, wv);
            { const int nwg_ = ts[32] * 4; if ((nwg_ - bid + nb - 1) / nb < (nwg_ + nb - 1) / nb) wconv_steal_in(q, l, lds, ts, 3, wv); } }
        SEAM(base + 10);
        for (int rep_ = 0; rep_ < 1 + ((PROBE_MASK >> 12) & 1); ++rep_) { LOADP();
            moe_table(q, l, ts, wv);
            pg8::Gemm g{Hid_, (const bf16_t*)(q.ws + WS_W + W_DN), MOE_ROWS, D, EH, EH, EH, (size_t)1024 * 512};
            pg8::ExpertOrder S{4, nb, bid, ts, (const unsigned*)(q.ws + WS_CTL) + CW_CNT + l * 32, (const int*)(q.ws + WS_LIST)};
            pg8::EpiScatter<pg8::ExpertOrder> E{Yexp_, D, &S};
            pg8::gemm_phase<pg8::EpiScatter<pg8::ExpertOrder>, pg8::ExpertOrder>(lds3, g, S, E, wv);
            { const int nwg_ = ts[32] * 4; if ((nwg_ - bid + nb - 1) / nb < (nwg_ + nb - 1) / nb) wconv_steal_in(q, l, lds, ts, 2, wv); } }
        SEAM(base + 11);
        for (int rep_ = 0; rep_ < 1 + ((PROBE_MASK >> 13) & 1); ++rep_) { LOADP(); wconv_steal_in(q, l, lds, ts, -1, wv); if ((PROBE_MASK >> 19) & 1) ph_ln2(q, l, M2, bid, nb, wv, 1); ph_ln2(q, l, M2, bid, nb, wv); }
        SEAM(base + 12);
    }
#undef IN
#undef SEAM
}

extern "C" void kernel_launch(void* const* d_in, const int* in_sizes, int n_in, void* d_out, int out_size, void* d_ws, size_t ws_size, hipStream_t stream) {
    static int grid = 0;
    if (grid == 0) {
        if (n_in != 30 || ws_size < WS_END) { fprintf(stderr, "kernel_launch: unexpected n_in %d or ws_size %zu\n", n_in, ws_size); grid = -1; return; }
        int dev = 0, cus = 0;
        if (hipGetDevice(&dev) != hipSuccess || hipDeviceGetAttribute(&cus, hipDeviceAttributeMultiprocessorCount, dev) != hipSuccess) { grid = -1; return; }
        if (hipFuncSetAttribute((const void*)fwd_kernel, hipFuncAttributeMaxDynamicSharedMemorySize, LDS_BYTES) != hipSuccess) { grid = -1; return; }
        int per_cu = 0;
        (void)hipOccupancyMaxActiveBlocksPerMultiprocessor(&per_cu, (const void*)fwd_kernel, NTHR, LDS_BYTES);
        (void)hipGetLastError();
        grid = cus;
    }
    if (grid < 0) return;
    (void)hipMemsetAsync((char*)d_ws + WS_CTL, 0, CTL_BYTES, stream);
    Params p{};
    for (int i = 0; i < 30; ++i) p.in[i] = (const float*)d_in[i];
    p.out = (float*)d_out; p.ws = (unsigned char*)d_ws;
#if MK_SINGLE
    p.ph_lo = 0; p.ph_hi = NPH;
    hipLaunchKernelGGL(fwd_kernel, dim3(grid), dim3(NTHR), LDS_BYTES, stream, p);
#else
    for (int ph = 0; ph < NPH; ++ph) { p.ph_lo = ph; p.ph_hi = ph + 1; hipLaunchKernelGGL(fwd_kernel, dim3(grid), dim3(NTHR), LDS_BYTES, stream, p); }
#endif
}
```
